# Optimizing an MI355X kernel written in HIP

```python
import jax, jax.numpy as jnp
from jax import lax
import numpy as np

D_MODEL = 1024
BATCH = 8
SEQ = 2048
DEPTH = 4
DEC_BATCH = 128
DEC_SEQ = 4
PAST_LEN = 16384
PAGE_SIZE = 128

N_AB = (DEPTH + 1) // 2
N_SSD = DEPTH // 2
ML_HEADS = 4
ML_DK = D_MODEL // 16
ML_DV = D_MODEL // 8
ML_QK = ML_HEADS * ML_DK
ML_V = ML_HEADS * ML_DV
GLA_HEADS = 4
GLA_DK = D_MODEL // 16
GLA_DV = D_MODEL // 8
GLA_QK = GLA_HEADS * GLA_DK
GLA_V = GLA_HEADS * GLA_DV
GLA_RANK = 16
GLA_TAU = 16.0
MIX_WIDTH = ML_V + GLA_V
AB_SPLITS = (ML_QK, ML_QK, ML_V, ML_V, ML_HEADS, ML_HEADS,
             GLA_QK, GLA_QK, GLA_V, GLA_V, GLA_RANK)
AB_IN = 2 * ML_QK + 2 * ML_V + 2 * ML_HEADS + 2 * GLA_QK + 2 * GLA_V + GLA_RANK
SSD_INNER = 2 * D_MODEL
SSD_HEADDIM = 64
SSD_HEADS = SSD_INNER // SSD_HEADDIM
SSD_STATE = 128
SSD_GROUPS = 4
SSD_HPG = SSD_HEADS // SSD_GROUPS
SSD_CONV = 4
SSD_CONV_DIM = SSD_INNER + 2 * SSD_GROUPS * SSD_STATE
SSD_IN = SSD_INNER + SSD_CONV_DIM + SSD_HEADS
D_FF = 4 * D_MODEL
CHUNK = 64
DN_ALPHA = (2 * DEPTH) ** 0.25
DN_BETA = (8 * DEPTH) ** -0.25
LN_EPS = 1e-5

kernel_name = "hybrid_mlstm_gla_ssd_deepnorm_step"


def _split(t, sizes):
    idx, acc = [], 0
    for s in sizes[:-1]:
        acc += s
        idx.append(acc)
    return jnp.split(t, idx, axis=-1)


def _chunk_len(T):
    return CHUNK if T % CHUNK == 0 else T


def _chunks(x, L):
    B, T = x.shape[:2]
    return jnp.moveaxis(x.reshape((B, T // L, L) + x.shape[2:]), 1, 0)


def _unchunk(y):
    NC, B, L = y.shape[:3]
    return jnp.moveaxis(y, 0, 1).reshape((B, NC * L) + y.shape[3:])


def _causal(L):
    return jnp.tril(jnp.ones((L, L), dtype=bool))


def _layernorm(x, g, b):
    xf = x.astype(jnp.float32)
    mu = xf.mean(-1, keepdims=True)
    var = jnp.square(xf - mu).mean(-1, keepdims=True)
    y = (xf - mu) * lax.rsqrt(var + LN_EPS) * g.astype(jnp.float32) + b.astype(jnp.float32)
    return y.astype(x.dtype)


def _headnorm(h, g):
    mu = h.mean(-1, keepdims=True)
    var = jnp.square(h - mu).mean(-1, keepdims=True)
    return (h - mu) * lax.rsqrt(var + LN_EPS) * g.astype(jnp.float32)


def _mlstm_chunk(carry, inp):
    C0, n0, m0 = carry
    q, k, v, ig, lf = inp
    L = q.shape[1]
    b = jnp.cumsum(lf, axis=1)
    g = b + m0[:, None, :]
    D = b[:, :, None, :] - b[:, None, :, :] + ig[:, None, :, :]
    D = jnp.where(_causal(L)[None, :, :, None], D, -jnp.inf)
    m = jnp.maximum(g, D.max(axis=2))
    w_intra = jnp.exp(D - m[:, :, None, :])
    w_inter = jnp.exp(g - m)
    s = jnp.einsum('bthk,bshk->btsh', q, k) * w_intra
    num = jnp.einsum('btsh,bshv->bthv', s, v) + w_inter[..., None] * jnp.einsum('bthk,bhkv->bthv', q, C0)
    den = s.sum(axis=2) + w_inter * jnp.einsum('bthk,bhk->bth', q, n0)
    h = num / jnp.maximum(jnp.abs(den), jnp.exp(-m))[..., None]
    mL = m[:, -1]
    wL = jnp.exp(D[:, -1] - mL[:, None, :])
    wL0 = jnp.exp(g[:, -1] - mL)
    C = wL0[..., None, None] * C0 + jnp.einsum('bsh,bshk,bshv->bhkv', wL, k, v)
    n = wL0[..., None] * n0 + jnp.einsum('bsh,bshk->bhk', wL, k)
    return (C, n, mL), h


def _gla_chunk(S0, inp):
    q, k, v, la = inp
    L = q.shape[1]
    A = jnp.cumsum(la, axis=1)
    diff = A[:, :, None] - A[:, None, :]
    diff = jnp.where(_causal(L)[None, :, :, None, None], diff, -jnp.inf)
    s = jnp.einsum('bthk,bshk,btshk->btsh', q, k, jnp.exp(diff))
    o = jnp.einsum('btsh,bshv->bthv', s, v) + jnp.einsum('bthk,bhkv->bthv', q * jnp.exp(A), S0)
    AL = A[:, -1]
    kd = k * jnp.exp(AL[:, None] - A)
    S = jnp.exp(AL)[..., None] * S0 + jnp.einsum('bshk,bshv->bhkv', kd, v)
    return S, o


def _ssd_chunk(h0, inp):
    x, Bm, Cm, dt, a = inp
    L = x.shape[1]
    cs = jnp.cumsum(a, axis=1)
    seg = cs[:, :, None] - cs[:, None]
    seg = jnp.where(_causal(L)[None, :, :, None, None], seg, -jnp.inf)
    w = jnp.exp(seg) * dt[:, None]
    CB = jnp.einsum('btgn,bsgn->btsg', Cm, Bm)
    y = jnp.einsum('btsg,btsgr,bsgrp->btgrp', CB, w, x)
    y = y + jnp.einsum('btgn,bgrpn->btgrp', Cm, h0) * jnp.exp(cs)[..., None]
    csL = cs[:, -1]
    wL = jnp.exp(csL[:, None] - cs) * dt
    h = jnp.exp(csL)[..., None, None] * h0 + jnp.einsum('bsgr,bsgrp,bsgn->bgrpn', wL, x, Bm)
    return h, y


def _ab_mixer(x, C0, n0, m0, S0, w_in, ig_bias, fg_bias, ml_norm, wa2, ba, gla_norm, w_out):
    B, T, _ = x.shape
    L = _chunk_len(T)
    f32 = jnp.float32
    mq, mk, mv, mo, mi, mf, gq, gk, gv, gg, ga = _split((x @ w_in).astype(f32), AB_SPLITS)
    q = mq.reshape(B, T, ML_HEADS, ML_DK)
    k = mk.reshape(B, T, ML_HEADS, ML_DK) * (ML_DK ** -0.5)
    v = mv.reshape(B, T, ML_HEADS, ML_DV)
    ig = mi + ig_bias.astype(f32)
    lf = jax.nn.log_sigmoid(mf + fg_bias.astype(f32))
    (C, n, m), h = lax.scan(_mlstm_chunk, (C0.astype(f32), n0.astype(f32), m0.astype(f32)),
                            (_chunks(q, L), _chunks(k, L), _chunks(v, L), _chunks(ig, L), _chunks(lf, L)))
    h = _headnorm(_unchunk(h), ml_norm.reshape(ML_HEADS, ML_DV))
    ml_out = h.reshape(B, T, ML_V) * jax.nn.sigmoid(mo)
    q2 = gq.reshape(B, T, GLA_HEADS, GLA_DK) * (GLA_DK ** -0.5)
    k2 = gk.reshape(B, T, GLA_HEADS, GLA_DK)
    v2 = gv.reshape(B, T, GLA_HEADS, GLA_DV)
    la = jax.nn.log_sigmoid(ga @ wa2.astype(f32) + ba.astype(f32)) / GLA_TAU
    la = la.reshape(B, T, GLA_HEADS, GLA_DK)
    S, o = lax.scan(_gla_chunk, S0.astype(f32),
                    (_chunks(q2, L), _chunks(k2, L), _chunks(v2, L), _chunks(la, L)))
    o = _headnorm(_unchunk(o), gla_norm.reshape(GLA_HEADS, GLA_DV))
    gla_out = o.reshape(B, T, GLA_V) * jax.nn.silu(gg)
    mix = jnp.concatenate([ml_out, gla_out], axis=-1).astype(x.dtype) @ w_out
    return mix, C.astype(C0.dtype), n.astype(n0.dtype), m.astype(m0.dtype), S.astype(S0.dtype)


def _ssd_mixer(x, h0, conv0, w_in, conv_w, conv_b, dt_bias, a_log, d_skip, norm_g, w_out):
    B, T, _ = x.shape
    L = _chunk_len(T)
    f32 = jnp.float32
    z, xbc, dtr = _split(x @ w_in, (SSD_INNER, SSD_CONV_DIM, SSD_HEADS))
    cat = jnp.concatenate([conv0.astype(xbc.dtype), xbc], axis=1)
    conv = conv_b.astype(f32)
    for w in range(SSD_CONV):
        conv = conv + cat[:, w:w + T].astype(f32) * conv_w[w].astype(f32)
    new_conv = cat[:, T:]
    xbc = jax.nn.silu(conv)
    xs, Bm, Cm = _split(xbc, (SSD_INNER, SSD_GROUPS * SSD_STATE, SSD_GROUPS * SSD_STATE))
    xs = xs.reshape(B, T, SSD_GROUPS, SSD_HPG, SSD_HEADDIM)
    Bm = Bm.reshape(B, T, SSD_GROUPS, SSD_STATE)
    Cm = Cm.reshape(B, T, SSD_GROUPS, SSD_STATE)
    dt = jax.nn.softplus(dtr.astype(f32) + dt_bias.astype(f32)).reshape(B, T, SSD_GROUPS, SSD_HPG)
    A = -jnp.exp(a_log.astype(f32)).reshape(SSD_GROUPS, SSD_HPG)
    h0f = h0.astype(f32).reshape(B, SSD_GROUPS, SSD_HPG, SSD_HEADDIM, SSD_STATE)
    h, y = lax.scan(_ssd_chunk, h0f,
                    (_chunks(xs, L), _chunks(Bm, L), _chunks(Cm, L), _chunks(dt, L), _chunks(dt * A, L)))
    y = _unchunk(y) + d_skip.astype(f32).reshape(SSD_GROUPS, SSD_HPG)[..., None] * xs
    y = y.reshape(B, T, SSD_INNER) * jax.nn.silu(z.astype(f32))
    yg = y.reshape(B, T, SSD_GROUPS, SSD_INNER // SSD_GROUPS)
    yg = yg * lax.rsqrt(jnp.square(yg).mean(-1, keepdims=True) + LN_EPS)
    y = yg.reshape(B, T, SSD_INNER) * norm_g.astype(f32)
    mix = y.astype(x.dtype) @ w_out
    h = h.reshape(B, SSD_HEADS, SSD_HEADDIM, SSD_STATE).astype(h0.dtype)
    return mix, h, new_conv.astype(conv0.dtype)


def _mlp(x, w1, w2):
    return jnp.square(jax.nn.relu(x @ w1)) @ w2


def _trunk(x, mC, mn, mm, gS, sh, sconv, P):
    nC, nn_, nm, nS, nh, nconv = [], [], [], [], [], []
    for l in range(DEPTH):
        j = l // 2
        if l % 2 == 0:
            mix, c, n, m, s = _ab_mixer(x, mC[j], mn[j], mm[j], gS[j], P['ab_w_in'][j], P['ab_ig_bias'][j],
                                        P['ab_fg_bias'][j], P['ab_ml_norm'][j], P['ab_gla_wa2'][j],
                                        P['ab_gla_ba'][j], P['ab_gla_norm'][j], P['ab_w_out'][j])
            nC.append(c); nn_.append(n); nm.append(m); nS.append(s)
        else:
            mix, h, cv = _ssd_mixer(x, sh[j], sconv[j], P['ssd_w_in'][j], P['ssd_conv_w'][j], P['ssd_conv_b'][j],
                                    P['ssd_dt_bias'][j], P['ssd_a_log'][j], P['ssd_d'][j], P['ssd_norm'][j],
                                    P['ssd_w_out'][j])
            nh.append(h); nconv.append(cv)
        x = _layernorm(DN_ALPHA * x + mix, P['ln_mix_g'][l], P['ln_mix_b'][l])
        x = _layernorm(DN_ALPHA * x + _mlp(x, P['mlp_w1'][l], P['mlp_w2'][l]), P['ln_mlp_g'][l], P['ln_mlp_b'][l])
    return x, jnp.stack(nC), jnp.stack(nn_), jnp.stack(nm), jnp.stack(nS), jnp.stack(nh), jnp.stack(nconv)


def setup_inputs(seed: int = 0) -> dict:
    key = jax.random.key(seed)
    keys = jax.random.split(key, 40)
    cnt = [0]

    def nk():
        cnt[0] += 1
        return keys[cnt[0] - 1]

    def nrm(shape, scale):
        return scale * jax.random.normal(nk(), shape, jnp.float32)

    def gain(shape):
        return 1.0 + 0.02 * jax.random.normal(nk(), shape, jnp.float32)

    u = jax.random.uniform(nk(), (N_SSD, SSD_HEADS), jnp.float32)
    dt0 = jnp.exp(np.log(1e-3) + u * (np.log(0.1) - np.log(1e-3)))
    dt_bias = dt0 + jnp.log(-jnp.expm1(-dt0))
    a_log = jnp.log(jax.random.uniform(nk(), (N_SSD, SSD_HEADS), jnp.float32, 1.0, 16.0))
    return {
        'x_prompt': nrm((BATCH, SEQ, D_MODEL), 1.0),
        'x_sample': nrm((DEC_BATCH, DEC_SEQ, D_MODEL), 1.0),
        'state_mlstm_C': nrm((N_AB, DEC_BATCH, ML_HEADS, ML_DK, ML_DV), 1.0),
        'state_mlstm_n': nrm((N_AB, DEC_BATCH, ML_HEADS, ML_DK), 1.0),
        'state_mlstm_m': nrm((N_AB, DEC_BATCH, ML_HEADS), 1.0),
        'state_gla_S': nrm((N_AB, DEC_BATCH, GLA_HEADS, GLA_DK, GLA_DV), 0.5),
        'state_ssd_h': nrm((N_SSD, DEC_BATCH, SSD_HEADS, SSD_HEADDIM, SSD_STATE), 0.5),
        'state_ssd_conv': nrm((N_SSD, DEC_BATCH, SSD_CONV - 1, SSD_CONV_DIM), 1.0),
        'ab_w_in': nrm((N_AB, D_MODEL, AB_IN), D_MODEL ** -0.5),
        'ab_ig_bias': nrm((N_AB, ML_HEADS), 0.1),
        'ab_fg_bias': 3.0 + nrm((N_AB, ML_HEADS), 0.5),
        'ab_ml_norm': gain((N_AB, ML_V)),
        'ab_gla_wa2': nrm((N_AB, GLA_RANK, GLA_QK), GLA_RANK ** -0.5),
        'ab_gla_ba': nrm((N_AB, GLA_QK), 0.1),
        'ab_gla_norm': gain((N_AB, GLA_V)),
        'ab_w_out': nrm((N_AB, MIX_WIDTH, D_MODEL), MIX_WIDTH ** -0.5 * DN_BETA),
        'ssd_w_in': nrm((N_SSD, D_MODEL, SSD_IN), D_MODEL ** -0.5),
        'ssd_conv_w': nrm((N_SSD, SSD_CONV, SSD_CONV_DIM), SSD_CONV ** -0.5),
        'ssd_conv_b': nrm((N_SSD, SSD_CONV_DIM), 0.01),
        'ssd_dt_bias': dt_bias,
        'ssd_a_log': a_log,
        'ssd_d': 1.0 + nrm((N_SSD, SSD_HEADS), 0.1),
        'ssd_norm': gain((N_SSD, SSD_INNER)),
        'ssd_w_out': nrm((N_SSD, SSD_INNER, D_MODEL), SSD_INNER ** -0.5 * DN_BETA),
        'mlp_w1': nrm((DEPTH, D_MODEL, D_FF), D_MODEL ** -0.5),
        'mlp_w2': nrm((DEPTH, D_FF, D_MODEL), D_FF ** -0.5 * DN_BETA),
        'ln_mix_g': gain((DEPTH, D_MODEL)),
        'ln_mix_b': nrm((DEPTH, D_MODEL), 0.01),
        'ln_mlp_g': gain((DEPTH, D_MODEL)),
        'ln_mlp_b': nrm((DEPTH, D_MODEL), 0.01),
    }


def reference(x_prompt, x_sample, state_mlstm_C, state_mlstm_n, state_mlstm_m, state_gla_S, state_ssd_h,
              state_ssd_conv, ab_w_in, ab_ig_bias, ab_fg_bias, ab_ml_norm, ab_gla_wa2, ab_gla_ba, ab_gla_norm,
              ab_w_out, ssd_w_in, ssd_conv_w, ssd_conv_b, ssd_dt_bias, ssd_a_log, ssd_d, ssd_norm, ssd_w_out,
              mlp_w1, mlp_w2, ln_mix_g, ln_mix_b, ln_mlp_g, ln_mlp_b):
    P = {'ab_w_in': ab_w_in, 'ab_ig_bias': ab_ig_bias, 'ab_fg_bias': ab_fg_bias, 'ab_ml_norm': ab_ml_norm,
         'ab_gla_wa2': ab_gla_wa2, 'ab_gla_ba': ab_gla_ba, 'ab_gla_norm': ab_gla_norm, 'ab_w_out': ab_w_out,
         'ssd_w_in': ssd_w_in, 'ssd_conv_w': ssd_conv_w, 'ssd_conv_b': ssd_conv_b, 'ssd_dt_bias': ssd_dt_bias,
         'ssd_a_log': ssd_a_log, 'ssd_d': ssd_d, 'ssd_norm': ssd_norm, 'ssd_w_out': ssd_w_out,
         'mlp_w1': mlp_w1, 'mlp_w2': mlp_w2, 'ln_mix_g': ln_mix_g, 'ln_mix_b': ln_mix_b,
         'ln_mlp_g': ln_mlp_g, 'ln_mlp_b': ln_mlp_b}
    Bp = x_prompt.shape[0]
    dtp = x_prompt.dtype
    z_C = jnp.zeros((N_AB, Bp, ML_HEADS, ML_DK, ML_DV), dtp)
    z_n = jnp.zeros((N_AB, Bp, ML_HEADS, ML_DK), dtp)
    z_m = jnp.zeros((N_AB, Bp, ML_HEADS), dtp)
    z_S = jnp.zeros((N_AB, Bp, GLA_HEADS, GLA_DK, GLA_DV), dtp)
    z_h = jnp.zeros((N_SSD, Bp, SSD_HEADS, SSD_HEADDIM, SSD_STATE), dtp)
    z_cv = jnp.zeros((N_SSD, Bp, SSD_CONV - 1, SSD_CONV_DIM), dtp)
    y_prompt, p_C, p_n, p_m, p_S, p_h, p_cv = _trunk(x_prompt, z_C, z_n, z_m, z_S, z_h, z_cv, P)
    y_sample, s_C, s_n, s_m, s_S, s_h, s_cv = _trunk(x_sample, state_mlstm_C, state_mlstm_n, state_mlstm_m,
                                                     state_gla_S, state_ssd_h, state_ssd_conv, P)
    return (y_prompt, y_sample, p_C, p_n, p_m, p_S, p_h, p_cv, s_C, s_n, s_m, s_S, s_h, s_cv)
```

```cpp
#include <hip/hip_runtime.h>
#include <hip/hip_cooperative_groups.h>
#include <cstdio>
namespace cg = cooperative_groups;

namespace pg8 {
#define PG8_LAS __attribute__((address_space(3)))
typedef unsigned short bf16_t;
typedef short bf16x8 __attribute__((ext_vector_type(8)));
typedef float f32x4 __attribute__((ext_vector_type(4)));
typedef unsigned u32x4 __attribute__((ext_vector_type(4)));
constexpr int BM = 256, BK = 64, HALF = 128, HTB = HALF * BK * 2  , STAGE_BYTES = 8 * HTB, NXCD = 8, WGM = 8;

__host__ __device__ __forceinline__ int lds_byte(int r, int c) { const int st = (r >> 4) * 2 + (c >> 5), rr = r & 15, cc = c & 31, ob = rr * 64 + cc * 2; return st * 1024 + (ob ^ (((ob >> 9) & 1) << 5)); }
__host__ __device__ __forceinline__ void stage_rc(int b, int& R, int& C) { const int st = b / 1024, sb = b % 1024, swz = sb ^ (((sb >> 9) & 1) << 5); R = (st >> 1) * 16 + swz / 64; C = (st & 1) * 32 + (swz % 64) / 2; }
__host__ __device__ __forceinline__ int perm32(int rho) { const int n = rho >> 4, i = rho & 15; return 8 * (i >> 2) + 4 * n + (i & 3); }

struct Unit { int pm, pn; };
struct Gemm { const bf16_t* A; const bf16_t* Bt; int M, N, K; };

struct StaticOrder {
    int nM, nN, nwg, G, c;
    __host__ __device__ void init(int M, int N, int G_, int c_) { nM = M / BM; nN = N / BM; nwg = nM * nN; G = G_; c = c_; }
    __host__ __device__ bool next(int i, Unit& u) const {
        const long L = (long)i * G + c; if (L >= nwg) return false;
        int wgid = (int)L; { const int q = nwg / NXCD, r = nwg % NXCD, xcd = wgid % NXCD, off = wgid / NXCD; wgid = (xcd < r ? xcd * (q + 1) : r * (q + 1) + (xcd - r) * q) + off; }
        const int nig = WGM * nN, gid = wgid / nig, fm = gid * WGM, gsz = (nM - fm) < WGM ? (nM - fm) : WGM;
        u.pm = fm + ((wgid % nig) % gsz); u.pn = (wgid % nig) / gsz; return true;
    }
    __device__ __forceinline__ void a_ready(const Unit&) const {}
    __device__ __forceinline__ void done(const Unit&) const {}
};
__device__ __forceinline__ unsigned cvt_pk_bf16(float lo, float hi) { unsigned r; asm volatile("v_cvt_pk_bf16_f32 %0, %1, %2" : "=v"(r) : "v"(lo), "v"(hi)); return r; }

template <int ACT  > struct EpiB {
    static constexpr bool PERM = true, AFTER_DRAIN = false;
    bf16_t* O; int ldc;
    __device__ __forceinline__ void operator()(const f32x4 (&acc)[2][2][4][2], const Unit& u, int wr, int wc, int fr, int fq) const {
        const int row0 = u.pm * BM + wr * 64 + fr, col0 = u.pn * BM + wc * 32 + 8 * fq;
#pragma unroll
        for (int ai = 0; ai < 2; ++ai)
#pragma unroll
            for (int m = 0; m < 4; ++m) { bf16_t* rowp = O + (size_t)(row0 + ai * HALF + m * 16) * ldc + col0;
#pragma unroll
                for (int bj = 0; bj < 2; ++bj) { f32x4 v0 = acc[ai][bj][m][0], v1 = acc[ai][bj][m][1];
                    if (ACT == 1) {
#pragma unroll
                        for (int q = 0; q < 4; ++q) { const float a = fmaxf(v0[q], 0.f), b = fmaxf(v1[q], 0.f); v0[q] = a * a; v1[q] = b * b; } }
                    u32x4 w; w.x = cvt_pk_bf16(v0[0], v0[1]); w.y = cvt_pk_bf16(v0[2], v0[3]); w.z = cvt_pk_bf16(v1[0], v1[1]); w.w = cvt_pk_bf16(v1[2], v1[3]);
                    *(u32x4*)(rowp + bj * HALF) = w; } }
    }
};
struct EpiRes {
    static constexpr bool PERM = false, AFTER_DRAIN = false;
    const float* X; float* Y; int ldc; float alpha;
    __device__ __forceinline__ void operator()(const f32x4 (&acc)[2][2][4][2], const Unit& u, int wr, int wc, int fr, int fq) const {
        const int row0 = u.pm * BM + wr * 64 + fr, col0 = u.pn * BM + wc * 32 + 4 * fq;
#pragma unroll
        for (int ai = 0; ai < 2; ++ai)
#pragma unroll
            for (int m = 0; m < 4; ++m) { const size_t off = (size_t)(row0 + ai * HALF + m * 16) * ldc + col0;
#pragma unroll
                for (int bj = 0; bj < 2; ++bj)
#pragma unroll
                    for (int n = 0; n < 2; ++n) { const f32x4 x = *(const f32x4*)(X + off + bj * HALF + n * 16); *(f32x4*)(Y + off + bj * HALF + n * 16) = x * alpha + acc[ai][bj][m][n]; }
                asm volatile("" ::: "memory"); }
    }
};

template <class Epi, class Sched, bool STAMP = false>
__device__ __forceinline__ void gemm_phase(PG8_LAS unsigned char* lds, const Gemm g, const Sched& S, const Epi& E, unsigned long long* stamps) {
    int tid_o = threadIdx.x; asm volatile("" : "+v"(tid_o)); const int tid = tid_o, wid = __builtin_amdgcn_readfirstlane(tid >> 6), lane = tid & 63, wr = wid >> 2, wc = wid & 3, fr = lane & 15, fq = lane >> 4;
    const int K = g.K, nt = K / BK;
    int ts_lo = 0, ts_hi = 0, nts = 0; const unsigned long long rt_entry = STAMP ? (unsigned long long)wall_clock64() : 0ull;
#define PG8_STAMP() do { if (STAMP && wid == 0 && nts < 64) { const unsigned long long _c = (unsigned long long)clock64(); \
        ts_lo = (lane == nts) ? (int)(unsigned)_c : ts_lo; ts_hi = (lane == nts) ? (int)(unsigned)(_c >> 32) : ts_hi; ++nts; } } while (0)
    PG8_STAMP();
    unsigned voffA[2], voffB[2];
#pragma unroll
    for (int i = 0; i < 2; ++i) { int R, C; stage_rc(tid * 16 + i * 8192, R, C); const int Rb = Epi::PERM ? ((R & ~31) + perm32(R & 31)) : R;
        voffA[i] = (unsigned)(R * K + C) * 2u; voffB[i] = (unsigned)(Rb * K + C) * 2u; }
    const size_t kstep = (size_t)(BK * 2);
    const size_t hstep = (size_t)HALF * K * 2;
    const size_t tstep = 2 * hstep;
    const unsigned ldsw = (unsigned)wid * 1024u;
    const int aoff = lds_byte(wr * 64 + fr, fq * 8), boff = lds_byte(wc * 32 + fr, fq * 8);
#define PG8_SA(b, h) (((b) * 2 + (h)) * HTB)
#define PG8_SB(b, h) ((4 + (b) * 2 + (h)) * HTB)
#define PG8_STAGE(bufoff, gbase, voff) do { _Pragma("unroll") for (int _i = 0; _i < 2; ++_i) \
        __builtin_amdgcn_global_load_lds((const unsigned*)((const char*)(gbase) + (voff)[_i]), (PG8_LAS unsigned*)(lds + (bufoff) + ldsw + _i * 8192), 16, 0, 0); } while (0)
#define PG8_LDA(dst, b, h) do { _Pragma("unroll") for (int m = 0; m < 4; ++m) _Pragma("unroll") for (int k = 0; k < 2; ++k) dst[m][k] = *(const PG8_LAS bf16x8*)(lds + PG8_SA(b, h) + aoff + m * 2048 + k * 1024); } while (0)
#define PG8_LDB(dst, b, h) do { _Pragma("unroll") for (int n = 0; n < 2; ++n) _Pragma("unroll") for (int k = 0; k < 2; ++k) dst[n][k] = *(const PG8_LAS bf16x8*)(lds + PG8_SB(b, h) + boff + n * 2048 + k * 1024); } while (0)
#define PG8_MMA(ai, bj, At, Bt) do { __builtin_amdgcn_s_setprio(1); _Pragma("unroll") for (int m = 0; m < 4; ++m) _Pragma("unroll") for (int n = 0; n < 2; ++n) _Pragma("unroll") for (int k = 0; k < 2; ++k) \
        acc[ai][bj][m][n] = __builtin_amdgcn_mfma_f32_16x16x32_bf16(Bt[n][k], At[m][k], acc[ai][bj][m][n], 0, 0, 0); __builtin_amdgcn_s_setprio(0); } while (0)
#define PG8_WAIT_V(n) asm volatile("s_waitcnt vmcnt(" #n ")" ::: "memory")
#define PG8_WAIT_L(n) asm volatile("s_waitcnt lgkmcnt(" #n ")" ::: "memory")
#define PG8_BAR __builtin_amdgcn_s_barrier()
#define PG8_SCHED __builtin_amdgcn_sched_barrier(0)
    Unit cur, nxt; int ui = 0;
    if (!S.next(0, cur)) return;
    f32x4 acc[2][2][4][2];
#pragma unroll
    for (int a = 0; a < 2; ++a)
#pragma unroll
        for (int b = 0; b < 2; ++b)
#pragma unroll
            for (int m = 0; m < 4; ++m)
#pragma unroll
                for (int n = 0; n < 2; ++n) acc[a][b][m][n] = (f32x4){0.f, 0.f, 0.f, 0.f};
    bf16x8 At[4][2], B0[2][2], B1[2][2];
    const char* cA = (const char*)g.A + (size_t)cur.pm * tstep; const char* cB = (const char*)g.Bt + (size_t)cur.pn * tstep;
    S.a_ready(cur);
    PG8_STAGE(PG8_SB(0, 0), cB, voffB); PG8_STAGE(PG8_SA(0, 0), cA, voffA); PG8_STAGE(PG8_SB(0, 1), cB + hstep, voffB); PG8_STAGE(PG8_SA(0, 1), cA + hstep, voffA);
    if (wr == 1) PG8_BAR;
    PG8_WAIT_V(4); PG8_BAR;
    PG8_STAGE(PG8_SB(1, 0), cB + kstep, voffB); PG8_STAGE(PG8_SA(1, 0), cA + kstep, voffA); PG8_STAGE(PG8_SB(1, 1), cB + hstep + kstep, voffB);
    PG8_WAIT_V(6); PG8_BAR;
    PG8_STAMP();
    for (;;) {
        const bool has_next = S.next(ui + 1, nxt);
        const char* nA = has_next ? (const char*)g.A + (size_t)nxt.pm * tstep : cA; const char* nB = has_next ? (const char*)g.Bt + (size_t)nxt.pn * tstep : cB;
        for (int t = 0; t < nt; t += 2) {
            const bool last = (t == nt - 2);
            const char* a1 = cA + (size_t)(t + 1) * kstep;
            const char* a2 = last ? nA : cA + (size_t)(t + 2) * kstep; const char* b2 = last ? nB : cB + (size_t)(t + 2) * kstep;
            const char* a3 = a2 + kstep; const char* b3 = b2 + kstep;
            if (last && has_next) S.a_ready(nxt);
            PG8_LDB(B0, 0, 0); PG8_SCHED; PG8_LDA(At, 0, 0); PG8_STAGE(PG8_SA(1, 1), a1 + hstep, voffA);
            PG8_WAIT_L(8); PG8_BAR; PG8_WAIT_L(0); PG8_MMA(0, 0, At, B0); PG8_BAR; PG8_SCHED;
            PG8_LDB(B1, 0, 1); PG8_STAGE(PG8_SB(0, 0), b2, voffB);
            PG8_BAR; PG8_WAIT_L(0); PG8_MMA(0, 1, At, B1); PG8_BAR;
            PG8_LDA(At, 0, 1); PG8_STAGE(PG8_SA(0, 0), a2, voffA);
            PG8_BAR; PG8_WAIT_L(0); PG8_MMA(1, 0, At, B0); PG8_BAR; PG8_SCHED;
            PG8_STAGE(PG8_SB(0, 1), b2 + hstep, voffB);
            PG8_WAIT_V(6); PG8_BAR; PG8_MMA(1, 1, At, B1); PG8_BAR;
            PG8_LDB(B0, 1, 0); PG8_SCHED; PG8_LDA(At, 1, 0); PG8_STAGE(PG8_SA(0, 1), a2 + hstep, voffA);
            PG8_WAIT_L(8); PG8_BAR; PG8_WAIT_L(0); PG8_MMA(0, 0, At, B0); PG8_BAR; PG8_SCHED;
            PG8_LDB(B1, 1, 1); PG8_STAGE(PG8_SB(1, 0), b3, voffB);
            PG8_BAR; PG8_WAIT_L(0); PG8_MMA(0, 1, At, B1); PG8_BAR;
            PG8_LDA(At, 1, 1); PG8_STAGE(PG8_SA(1, 0), a3, voffA);
            PG8_BAR; PG8_WAIT_L(0); PG8_MMA(1, 0, At, B0); PG8_BAR; PG8_SCHED;
            PG8_STAGE(PG8_SB(1, 1), b3 + hstep, voffB);
            PG8_WAIT_V(6); PG8_BAR; PG8_MMA(1, 1, At, B1); PG8_BAR;
        }
        PG8_STAMP();
        if constexpr (!Epi::AFTER_DRAIN) { E(acc, cur, wr, wc, fr, fq); S.done(cur); }
        PG8_STAMP();
        if (!has_next) break;
#pragma unroll
        for (int a = 0; a < 2; ++a)
#pragma unroll
            for (int b = 0; b < 2; ++b)
#pragma unroll
                for (int m = 0; m < 4; ++m)
#pragma unroll
                    for (int n = 0; n < 2; ++n) acc[a][b][m][n] = (f32x4){0.f, 0.f, 0.f, 0.f};
        cur = nxt; cA = nA; cB = nB; ++ui;
    }
    PG8_WAIT_V(0);
    if (wr == 0) PG8_BAR;
    PG8_BAR;
    if constexpr (Epi::AFTER_DRAIN) { E.fused(acc, cur, wr, wc, fr, fq, lds, wid, lane); S.done(cur); }
    PG8_STAMP();
    if (STAMP && wid == 0) { stamps[lane] = lane < nts ? (((unsigned long long)(unsigned)ts_hi << 32) | (unsigned)ts_lo) : 0ull;
        if (lane == 62) stamps[62] = rt_entry; if (lane == 63) stamps[63] = (unsigned long long)wall_clock64(); }
#undef PG8_STAMP
#undef PG8_SA
#undef PG8_SB
#undef PG8_STAGE
#undef PG8_LDA
#undef PG8_LDB
#undef PG8_MMA
#undef PG8_WAIT_V
#undef PG8_WAIT_L
#undef PG8_BAR
#undef PG8_SCHED
}
}

#define LAS __attribute__((address_space(3)))
typedef unsigned short bf16_t;
typedef short bf16x8 __attribute__((ext_vector_type(8)));
typedef float f32x4 __attribute__((ext_vector_type(4)));
typedef unsigned u32x4 __attribute__((ext_vector_type(4)));
typedef unsigned u32x2 __attribute__((ext_vector_type(2)));

constexpr int MP = 16384, MS = 512, MT = MP + MS;
constexpr int DM = 1024, DFF = 4096;
constexpr int ABN = 3072, ABSRC = 3096, SSDN = 5120, SSDSRC = 5152;
constexpr int NITEM = 1536;
constexpr float LN_EPS = 1e-5f;
constexpr float DN_ALPHA = 1.6817928305074290861f;

constexpr size_t MiB = (size_t)1 << 20;
constexpr size_t WS_CTL = 0, CTL_BYTES = 16384;
constexpr size_t WS_WABIN = 1 * MiB, WS_WABG = 13 * MiB, WS_WABOUT = 14 * MiB, WS_WSSDIN = 18 * MiB, WS_WSSDG = 38 * MiB, WS_WSSDOUT = 39 * MiB;
constexpr size_t WS_W1 = 47 * MiB, WS_W2 = 79 * MiB;
constexpr size_t WS_XF = 112 * MiB, WS_XB = 178 * MiB, WS_Y = 211 * MiB, WS_P = 277 * MiB  , WS_MIX = 442 * MiB, WS_YG = 508 * MiB;
constexpr size_t WS_GT = 574 * MiB, WS_SQ = 577 * MiB, WS_DCT = 580 * MiB, WS_CINT = 676 * MiB, WS_ACUM = 724 * MiB, WS_DN = 748 * MiB, WS_NIN = 749 * MiB, WS_DEC = 750 * MiB, WS_SCAL = 751 * MiB;
constexpr size_t WS_END = 752 * MiB;

constexpr size_t O_YP = 0, O_YS = 16777216, O_PC = O_YS + 524288, O_PN = O_PC + 524288, O_PM = O_PN + 4096, O_PS = O_PM + 64, O_PH = O_PS + 524288, O_PCV = O_PH + 4194304;
constexpr size_t O_SC = O_PCV + 147456, O_SN = O_SC + 8388608, O_SM = O_SN + 65536, O_SS = O_SM + 1024, O_SH = O_SS + 8388608, O_SCV = O_SH + 67108864, O_END = O_SCV + 2359296;

constexpr int LDS_BAR_OFF = 131072, LDS_BYTES = 131072 + 256;

struct Params { const float* in[30]; float* out; unsigned char* ws; };

__device__ __forceinline__ int otid() { int t = threadIdx.x; asm volatile("" : "+v"(t)); return t; }
__device__ __forceinline__ float bf2f(bf16_t v) { return __uint_as_float(((unsigned)v) << 16); }
__device__ __forceinline__ bf16_t f2bf(float f) { unsigned u = __float_as_uint(f); u += 0x7fffu + ((u >> 16) & 1u); return (bf16_t)(u >> 16); }
__device__ __forceinline__ unsigned pk2(float lo, float hi) { return (unsigned)f2bf(lo) | ((unsigned)f2bf(hi) << 16); }
__device__ __forceinline__ float bfe(const u32x4& v, int e) { const unsigned w = v[e >> 1]; return __uint_as_float((e & 1) ? (w & 0xffff0000u) : (w << 16)); }
__device__ __forceinline__ bf16_t bfr(const u32x4& v, int e) { const unsigned w = v[e >> 1]; return (bf16_t)((e & 1) ? (w >> 16) : (w & 0xffffu)); }
__device__ __forceinline__ float logsig(float x) { return fminf(x, 0.f) - log1pf(__expf(-fabsf(x))); }
__device__ __forceinline__ float softplusf(float x) { return fmaxf(x, 0.f) + log1pf(__expf(-fabsf(x))); }
__device__ __forceinline__ float sigm(float x) { return 1.f / (1.f + __expf(-x)); }
__device__ __forceinline__ float wave_sum(float v) {
#pragma unroll
    for (int o = 32; o >= 1; o >>= 1) v += __shfl_xor(v, o);
    return v; }
__device__ __forceinline__ float wave_max(float v) {
#pragma unroll
    for (int o = 32; o >= 1; o >>= 1) v = fmaxf(v, __shfl_xor(v, o));
    return v; }
__device__ __forceinline__ float wave_scan_add(float v, int lane) {
#pragma unroll
    for (int o = 1; o < 64; o <<= 1) { const float t = __shfl_up(v, o); if (lane >= o) v += t; }
    return v; }
__device__ __forceinline__ float wave_scan_max(float v, int lane) {
#pragma unroll
    for (int o = 1; o < 64; o <<= 1) { const float t = __shfl_up(v, o); if (lane >= o) v = fmaxf(v, t); }
    return v; }
__device__ __forceinline__ f32x4 mma(bf16x8 a, bf16x8 b, f32x4 c) { return __builtin_amdgcn_mfma_f32_16x16x32_bf16(a, b, c, 0, 0, 0); }
__device__ __forceinline__ bf16x8 ldsfrag(const LAS bf16_t* base, int row0, int ld, int k0, int lane) {
    return *(const LAS bf16x8*)(base + (row0 + (lane & 15)) * ld + k0 + (lane >> 4) * 8); }

#define XB_TMO      128
#define XB_XCNT(j)  (256  + 64 * (j))
#define XB_XSUB(j)  (1280 + 64 * (j))
#define XB_XGEN(j)  (2304 + 64 * (j))
#define XB_TOP      3328
#define XB_TOPGEN   3392
#define XCD_BAR_WORDS 3456
#define XB_SPIN_CAP (1u << 18)
__device__ __forceinline__ unsigned xb_ld(unsigned* p)              { return __hip_atomic_load(p, __ATOMIC_RELAXED, __HIP_MEMORY_SCOPE_AGENT); }
__device__ __forceinline__ unsigned xb_add(unsigned* p, unsigned v) { return __hip_atomic_fetch_add(p, v, __ATOMIC_RELAXED, __HIP_MEMORY_SCOPE_AGENT); }
__device__ __forceinline__ unsigned xb_xcc_id() { return (unsigned)__builtin_amdgcn_s_getreg((3 << 11) | 20) & 0xFu; }
#define XB_SPIN(cond, bar) do { unsigned _sp = 0; while (cond) { __builtin_amdgcn_s_sleep(1); \
    if ((++_sp & 255u) == 0u) { if (xb_ld(&(bar)[XB_TMO])) break; if (_sp > XB_SPIN_CAP) { atomicAdd(&(bar)[XB_TMO], 1u); break; } } } } while (0)
struct XcdBarrier { unsigned* bar; unsigned x; volatile LAS unsigned* st; };
__device__ __forceinline__ XcdBarrier xcd_barrier_post(unsigned* bar, volatile LAS unsigned* st) {
    XcdBarrier b; b.bar = bar; b.x = xb_xcc_id(); b.st = st;
    if (threadIdx.x == 0) (void)xb_add(&bar[XB_XCNT(b.x)], 1u);
    return b;
}
__device__ __forceinline__ void xcd_barrier_complete(unsigned* bar, unsigned x, unsigned& nloc, unsigned& nx) {
    const unsigned G = gridDim.x * gridDim.y * gridDim.z;
    unsigned sum, cnt, mine, sp = 0u;
    for (;;) {
        sum = 0u; cnt = 0u; mine = 0u;
#pragma unroll
        for (unsigned j = 0; j < 16; ++j) { const unsigned c = xb_ld(&bar[XB_XCNT(j)]); sum += c; cnt += (c > 0u) ? 1u : 0u; mine = (j == x) ? c : mine; }
        if (sum == G) break;
        __builtin_amdgcn_s_sleep(1);
        if ((++sp & 255u) == 0u) { if (xb_ld(&bar[XB_TMO])) break; if (sp > XB_SPIN_CAP) { atomicAdd(&bar[XB_TMO], 1u); break; } }
    }
    nloc = mine > 0u ? mine : 1u; nx = cnt > 0u ? cnt : 1u;
}
__device__ __forceinline__ void xcd_barrier(const XcdBarrier& b) {
    asm volatile("s_waitcnt vmcnt(0)" ::: "memory");
    __syncthreads();
    if (threadIdx.x == 0) {
        unsigned* bar = b.bar;
        __builtin_amdgcn_s_waitcnt(0);
        unsigned nloc = b.st[0], nx = b.st[1];
        if (nloc == 0u) { xcd_barrier_complete(bar, b.x, nloc, nx); b.st[0] = nloc; b.st[1] = nx; }
        const unsigned old = xb_add(&bar[XB_XSUB(b.x)], 1u);
        const unsigned gen = old / nloc;
        if (old + 1u == (gen + 1u) * nloc) {
            __builtin_amdgcn_fence(__ATOMIC_RELEASE, "agent");
            asm volatile("s_waitcnt vmcnt(0)" ::: "memory");
            const unsigned og = xb_add(&bar[XB_TOP], 1u);
            const unsigned tg = og / nx;
            if (og + 1u == (tg + 1u) * nx) xb_add(&bar[XB_TOPGEN], 1u);
            else XB_SPIN(xb_ld(&bar[XB_TOPGEN]) == tg, bar);
            __builtin_amdgcn_fence(__ATOMIC_ACQUIRE, "agent");
            xb_add(&bar[XB_XGEN(b.x)], 1u);
            asm volatile("s_waitcnt vmcnt(0)" ::: "memory");
        } else {
            XB_SPIN(xb_ld(&bar[XB_XGEN(b.x)]) == gen, bar);
            __builtin_amdgcn_fence(__ATOMIC_ACQUIRE, "agent");
            asm volatile("s_waitcnt vmcnt(0)" ::: "memory");
        }
    }
    __syncthreads();
}

__device__ __forceinline__ void p0_prologue(const Params& P, LAS unsigned char* lds) {
    const int tid = otid();
    LAS float* tileb = (LAS float*)lds;
    int it = 0;
    for (int t = blockIdx.x; t < 13824; t += gridDim.x, ++it) {
        const float* src; bf16_t* dst; int K, ldS, r, special = 0;
        if (t < 1536)      { const int j = t / 768; r = t % 768; src = P.in[8] + (size_t)j * 1024 * ABSRC; ldS = ABSRC; K = 1024; dst = (bf16_t*)(P.ws + WS_WABIN) + (size_t)j * ABN * 1024; special = 1; }
        else if (t < 2048) { const int q = t - 1536, j = q / 256; r = q % 256; src = P.in[15] + (size_t)j * 1024 * 1024; ldS = 1024; K = 1024; dst = (bf16_t*)(P.ws + WS_WABOUT) + (size_t)j * 1024 * 1024; }
        else if (t < 4608) { const int q = t - 2048, j = q / 1280; r = q % 1280; src = P.in[16] + (size_t)j * 1024 * SSDSRC; ldS = SSDSRC; K = 1024; dst = (bf16_t*)(P.ws + WS_WSSDIN) + (size_t)j * SSDN * 1024; }
        else if (t < 5632) { const int q = t - 4608, j = q / 512; r = q % 512; src = P.in[23] + (size_t)j * 2048 * 1024; ldS = 1024; K = 2048; dst = (bf16_t*)(P.ws + WS_WSSDOUT) + (size_t)j * 1024 * 2048; }
        else if (t < 9728) { const int q = t - 5632, l = q / 1024; r = q % 1024; src = P.in[24] + (size_t)l * 1024 * 4096; ldS = 4096; K = 1024; dst = (bf16_t*)(P.ws + WS_W1) + (size_t)l * 4096 * 1024; }
        else               { const int q = t - 9728, l = q / 1024; r = q % 1024; src = P.in[25] + (size_t)l * 4096 * 1024; ldS = 1024; K = 4096; dst = (bf16_t*)(P.ws + WS_W2) + (size_t)l * 1024 * 4096; }
        const int nkt = K >> 6, kt = r % nkt, nt = r / nkt, k0 = kt * 64, n0 = nt * 64;
        const int scol0 = n0 + ((special && n0 >= 1536) ? 8 : 0);
        LAS float* tile = tileb + (it & 1) * (64 * 65);
        { const int rr = tid >> 4, c4 = (tid & 15) * 4;
#pragma unroll
          for (int h2 = 0; h2 < 2; ++h2) { const int k = rr + h2 * 32; const f32x4 v = *(const f32x4*)(src + (size_t)(k0 + k) * ldS + scol0 + c4);
              tile[k * 65 + c4 + 0] = v[0]; tile[k * 65 + c4 + 1] = v[1]; tile[k * 65 + c4 + 2] = v[2]; tile[k * 65 + c4 + 3] = v[3]; } }
        __syncthreads();
        { const int n = tid >> 3, kv = (tid & 7) * 8; u32x4 w;
          w.x = pk2(tile[(kv + 0) * 65 + n], tile[(kv + 1) * 65 + n]); w.y = pk2(tile[(kv + 2) * 65 + n], tile[(kv + 3) * 65 + n]);
          w.z = pk2(tile[(kv + 4) * 65 + n], tile[(kv + 5) * 65 + n]); w.w = pk2(tile[(kv + 6) * 65 + n], tile[(kv + 7) * 65 + n]);
          *(u32x4*)(dst + (size_t)(n0 + n) * K + k0 + kv) = w; }
    }
    const int gtid = blockIdx.x * 512 + tid, gsz = gridDim.x * 512;
    for (int idx = gtid; idx < 4 * 32 * 1024; idx += gsz) {
        const int which = idx >> 15, n = (idx >> 10) & 31, k = idx & 1023; float v = 0.f;
        if (which < 2) { const int col = n < 4 ? 1536 + n : (n < 8 ? 1540 + (n - 4) : (n < 24 ? 3080 + (n - 8) : -1));
            if (col >= 0) v = P.in[8][((size_t)which * 1024 + k) * ABSRC + col];
            ((bf16_t*)(P.ws + WS_WABG))[(size_t)which * 32768 + n * 1024 + k] = f2bf(v); }
        else { const int j = which - 2; v = P.in[16][((size_t)j * 1024 + k) * SSDSRC + 5120 + n];
            ((bf16_t*)(P.ws + WS_WSSDG))[(size_t)j * 32768 + n * 1024 + k] = f2bf(v); }
    }
    { const f32x4* xp = (const f32x4*)P.in[0]; const f32x4* xs = (const f32x4*)P.in[1]; f32x4* XF = (f32x4*)(P.ws + WS_XF); u32x2* XB = (u32x2*)(P.ws + WS_XB);
      for (int idx = gtid; idx < MT * 256; idx += gsz) { const f32x4 v = idx < MP * 256 ? xp[idx] : xs[idx - MP * 256]; XF[idx] = v; u32x2 w; w.x = pk2(v[0], v[1]); w.y = pk2(v[2], v[3]); XB[idx] = w; } }
}

__device__ __forceinline__ void gates_phase(const bf16_t* XB, const bf16_t* Gt, float* GT) {
    const int tid = otid(), lane = tid & 63, wave = tid >> 6;
    const int gw = blockIdx.x * 8 + wave, nw = gridDim.x * 8;
    for (int task = gw; task < MT / 16; task += nw) {
        const int m0 = task * 16;
        f32x4 a0 = {0.f, 0.f, 0.f, 0.f}, a1 = {0.f, 0.f, 0.f, 0.f};
        const bf16_t* ap = XB + (size_t)(m0 + (lane & 15)) * 1024 + (lane >> 4) * 8;
        const bf16_t* bp = Gt + (size_t)(lane & 15) * 1024 + (lane >> 4) * 8;
#pragma unroll 4
        for (int ks = 0; ks < 32; ++ks) { const bf16x8 a = *(const bf16x8*)(ap + ks * 32); const bf16x8 b0 = *(const bf16x8*)(bp + ks * 32); const bf16x8 b1 = *(const bf16x8*)(bp + 16 * 1024 + ks * 32);
            a0 = mma(a, b0, a0); a1 = mma(a, b1, a1); }
#pragma unroll
        for (int r = 0; r < 4; ++r) { const int row = m0 + (lane >> 4) * 4 + r; GT[(size_t)(lane & 15) * MT + row] = a0[r]; GT[(size_t)(16 + (lane & 15)) * MT + row] = a1[r]; }
    }
}

__device__ __forceinline__ void ln_phase(const float* Y, const float* g, const float* bta, float* XF, bf16_t* XB) {
    const int tid = otid(), lane = tid & 63, wave = tid >> 6;
    const int gw = blockIdx.x * 8 + wave, nw = gridDim.x * 8;
    for (int row = gw; row < MT; row += nw) {
        const f32x4* y = (const f32x4*)(Y + (size_t)row * 1024);
        f32x4 v[4]; float s = 0.f;
#pragma unroll
        for (int i = 0; i < 4; ++i) { v[i] = y[lane + 64 * i]; s += (v[i][0] + v[i][1]) + (v[i][2] + v[i][3]); }
        const float mean = wave_sum(s) * (1.f / 1024.f); float q = 0.f;
#pragma unroll
        for (int i = 0; i < 4; ++i) { v[i] = v[i] - mean; q += (v[i][0] * v[i][0] + v[i][1] * v[i][1]) + (v[i][2] * v[i][2] + v[i][3] * v[i][3]); }
        const float rstd = rsqrtf(wave_sum(q) * (1.f / 1024.f) + LN_EPS);
#pragma unroll
        for (int i = 0; i < 4; ++i) { const f32x4 gg = ((const f32x4*)g)[lane + 64 * i], bb = ((const f32x4*)bta)[lane + 64 * i]; const f32x4 o = v[i] * rstd * gg + bb;
            ((f32x4*)(XF + (size_t)row * 1024))[lane + 64 * i] = o; u32x2 w; w.x = pk2(o[0], o[1]); w.y = pk2(o[2], o[3]); ((u32x2*)(XB + (size_t)row * 1024))[lane + 64 * i] = w; }
    }
}

struct AbItem { int samp, b, h, c, m0, nvalid; };
__device__ __forceinline__ AbItem ab_decode(int i) {
    AbItem t; t.samp = i >= 1024;
    if (!t.samp) { t.b = i >> 7; t.h = (i >> 5) & 3; t.c = i & 31; t.m0 = t.b * 2048 + t.c * 64; t.nvalid = 64; }
    else { const int r = i - 1024; t.b = r >> 2; t.h = r & 3; t.c = 0; t.m0 = MP + t.b * 4; t.nvalid = 4; }
    return t;
}
__device__ __forceinline__ void stage_vt(LAS bf16_t* VT, const bf16_t* Pb, int m0, int vcol, int nvalid, int tid) {
    const int s = tid >> 3, v16 = (tid & 7) * 16;
    u32x4 a = {0u, 0u, 0u, 0u}, b = {0u, 0u, 0u, 0u};
    if (s < nvalid) { const bf16_t* p = Pb + (size_t)(m0 + s) * ABN + vcol + v16; a = *(const u32x4*)p; b = *(const u32x4*)(p + 8); }
#pragma unroll
    for (int e = 0; e < 8; ++e) { VT[(v16 + e) * 72 + s] = bfr(a, e); VT[(v16 + 8 + e) * 72 + s] = bfr(b, e); }
}

template <int TYPE> __device__ __forceinline__ void ab_delta_item(const Params& P, LAS unsigned char* lds, int j, int i) {
    const int tid = otid(), lane = tid & 63, wave = tid >> 6;
    const AbItem it = ab_decode(i);
    const int b = it.b, h = it.h, c = it.c, m0 = it.m0, nvalid = it.nvalid;
    LAS bf16_t* KT = (LAS bf16_t*)lds; LAS bf16_t* VT = (LAS bf16_t*)(lds + 9216);
    const bf16_t* Pb = (const bf16_t*)(P.ws + WS_P);
    const float* GT = (const float*)(P.ws + WS_GT);
    const int kcol = TYPE == 0 ? 256 + h * 64 : 1792 + h * 64, vcol = TYPE == 0 ? 512 + h * 128 : 2048 + h * 128;
    if (TYPE == 0) {
        LAS float* bt = (LAS float*)(lds + 27648); LAS float* igt = bt + 64; LAS float* scb = bt + 128; LAS float* sca = bt + 160;
        const float igb = P.in[9][j * 4 + h], fgb = P.in[10][j * 4 + h];
        for (int cc = wave; cc <= c; cc += 8) {
            const int row = (it.samp ? m0 : b * 2048 + cc * 64) + lane; const bool valid = lane < nvalid;
            float lf = 0.f, ig = -INFINITY;
            if (valid) { lf = logsig(GT[(size_t)(4 + h) * MT + row] + fgb); ig = GT[(size_t)h * MT + row] + igb; }
            const float bs = wave_scan_add(lf, lane); const float am = wave_max(ig - bs);
            if (cc == c) { bt[lane] = bs; igt[lane] = ig; }
            if (lane == 63) scb[cc] = bs;
            if (lane == 0) sca[cc] = am;
        }
        __syncthreads();
        float mprev = it.samp ? P.in[4][(j * 128 + b) * 4 + h] : 0.f;
        for (int cc = 0; cc < c; ++cc) mprev = scb[cc] + fmaxf(mprev, sca[cc]);
        const float bL = scb[c], aL = sca[c]; const float mL = bL + fmaxf(mprev, aL); const float wL0 = __expf(bL + mprev - mL);
        { const int s = tid >> 3, d8 = (tid & 7) * 8; u32x4 kv = {0u, 0u, 0u, 0u}; float wl = 0.f;
          if (s < nvalid) { kv = *(const u32x4*)(Pb + (size_t)(m0 + s) * ABN + kcol + d8); wl = 0.125f * __expf(bL - bt[s] + igt[s] - mL); }
#pragma unroll
          for (int e = 0; e < 8; ++e) KT[(d8 + e) * 72 + s] = f2bf(bfe(kv, e) * wl); }
        if (tid == 0) { float* sc = (float*)(P.ws + WS_SCAL) + (size_t)i * 4; sc[0] = mprev; sc[1] = wL0; sc[2] = mL;
            if (it.samp) P.out[O_SM + (j * 128 + b) * 4 + h] = mL; else if (c == 31) P.out[O_PM + (j * 8 + b) * 4 + h] = mL; }
    } else {
        LAS float* gaL = (LAS float*)(lds + 28672); LAS float* Ac = (LAS float*)(lds + 32768); LAS float* seg = (LAS float*)(lds + 49408);
#pragma unroll
        for (int q = 0; q < 2; ++q) { const int idx = tid + q * 512, r = idx >> 6, s = idx & 63; gaL[idx] = (s < nvalid) ? GT[(size_t)(8 + r) * MT + m0 + s] : 0.f; }
        __syncthreads();
        const int dk = tid & 63, sg = tid >> 6;
        float wcv[16];
#pragma unroll
        for (int r = 0; r < 16; ++r) wcv[r] = P.in[12][(size_t)(j * 16 + r) * 256 + h * 64 + dk];
        const float bias = P.in[13][j * 256 + h * 64 + dk];
        float loc[8]; float run = 0.f;
#pragma unroll
        for (int ss = 0; ss < 8; ++ss) { const int s = sg * 8 + ss; float la = 0.f;
            if (s < nvalid) { float z = bias;
#pragma unroll
                for (int r = 0; r < 16; ++r) z += gaL[r * 64 + s] * wcv[r];
                la = logsig(z) * (1.f / 16.f); }
            run += la; loc[ss] = run; }
        seg[sg * 64 + dk] = run;
        __syncthreads();
        float off = 0.f;
#pragma unroll
        for (int g2 = 0; g2 < 8; ++g2) off += (g2 < sg) ? seg[g2 * 64 + dk] : 0.f;
        float* acg = (float*)(P.ws + WS_ACUM) + (size_t)i * 4096;
#pragma unroll
        for (int ss = 0; ss < 8; ++ss) { const int s = sg * 8 + ss; const float a = loc[ss] + off; Ac[s * 65 + dk] = a; acg[s * 64 + dk] = a; }
        __syncthreads();
        { const int s = tid >> 3, d8 = (tid & 7) * 8; u32x4 kv = {0u, 0u, 0u, 0u};
          if (s < nvalid) kv = *(const u32x4*)(Pb + (size_t)(m0 + s) * ABN + kcol + d8);
#pragma unroll
          for (int e = 0; e < 8; ++e) { const int d = d8 + e; const float wgt = __expf(Ac[63 * 65 + d] - Ac[s * 65 + d]); KT[d * 72 + s] = f2bf(bfe(kv, e) * wgt); } }
        if (tid < 64) ((float*)(P.ws + WS_DEC))[(size_t)i * 64 + tid] = __expf(Ac[63 * 65 + tid]);
    }
    stage_vt(VT, Pb, m0, vcol, nvalid, tid);
    __syncthreads();
    f32x4 acc[4];
#pragma unroll
    for (int jj = 0; jj < 4; ++jj) acc[jj] = (f32x4){0.f, 0.f, 0.f, 0.f};
#pragma unroll
    for (int ks = 0; ks < 2; ++ks) { const bf16x8 a = ldsfrag(VT, wave * 16, 72, ks * 32, lane);
#pragma unroll
        for (int jj = 0; jj < 4; ++jj) { const bf16x8 bb = ldsfrag(KT, jj * 16, 72, ks * 32, lane); acc[jj] = mma(a, bb, acc[jj]); } }
    float* dct = (float*)(P.ws + WS_DCT) + (size_t)(TYPE * NITEM + i) * 8192;
#pragma unroll
    for (int jj = 0; jj < 4; ++jj)
#pragma unroll
        for (int r = 0; r < 4; ++r) dct[(wave * 16 + (lane >> 4) * 4 + r) * 64 + jj * 16 + (lane & 15)] = acc[jj][r];
    if (TYPE == 0 && tid < 64) { float sa = 0.f;
        for (int s = 0; s < 64; ++s) sa += bf2f(KT[tid * 72 + s]);
        ((float*)(P.ws + WS_DN))[(size_t)i * 64 + tid] = sa; }
    __syncthreads();
}

__device__ __forceinline__ void ab_scan_phase(const Params& P, LAS unsigned char* lds, int j) {
    const int tid = otid();
    const float* DCT = (const float*)(P.ws + WS_DCT); bf16_t* CINT = (bf16_t*)(P.ws + WS_CINT);
    const float* SCAL = (const float*)(P.ws + WS_SCAL); const float* DEC = (const float*)(P.ws + WS_DEC);
    const float* DN = (const float*)(P.ws + WS_DN); float* NIN = (float*)(P.ws + WS_NIN);
    for (int task = blockIdx.x; task < 256 + 1024; task += gridDim.x) {
        if (task < 256) {
            const int type = task >> 7, seq = (task >> 2) & 31, q = task & 3, b = seq >> 2, h = seq & 3;
            const int e = q * 2048 + tid * 4;
            f32x4 st = {0.f, 0.f, 0.f, 0.f};
#pragma unroll 4
            for (int c = 0; c < 32; ++c) { const int i = seq * 32 + c; const size_t base = (size_t)(type * NITEM + i) * 8192 + e;
                const f32x4 d = *(const f32x4*)(DCT + base);
                f32x4 dec; if (type == 0) { const float w = SCAL[i * 4 + 1]; dec = (f32x4){w, w, w, w}; } else dec = *(const f32x4*)(DEC + (size_t)i * 64 + (e & 63));
                u32x2 w2; w2.x = pk2(st[0], st[1]); w2.y = pk2(st[2], st[3]); *(u32x2*)(CINT + base) = w2;
                st = dec * st + d; }
            float* out = P.out + (type == 0 ? O_PC : O_PS) + (size_t)((j * 8 + b) * 4 + h) * 8192;
            const int dv = e >> 6, dk = e & 63;
#pragma unroll
            for (int jj = 0; jj < 4; ++jj) out[(dk + jj) * 128 + dv] = st[jj];
            if (type == 0 && q == 0 && tid < 64) { float ns = 0.f;
                for (int c = 0; c < 32; ++c) { const int i = seq * 32 + c; NIN[(size_t)i * 64 + tid] = ns; ns = SCAL[i * 4 + 1] * ns + DN[(size_t)i * 64 + tid]; }
                P.out[O_PN + (size_t)((j * 8 + b) * 4 + h) * 64 + tid] = ns; }
        } else {
            const int r = task - 256, type = r >> 9, bh = r & 511, b = bh >> 2, h = bh & 3, i = 1024 + bh;
            LAS float* T1 = (LAS float*)lds; LAS float* T2 = (LAS float*)(lds + 33280);
            const size_t base = (size_t)(type * NITEM + i) * 8192;
#pragma unroll
            for (int k = 0; k < 4; ++k) { const int e = tid * 4 + k * 2048; const f32x4 d = *(const f32x4*)(DCT + base + e); const int dv = e >> 6, dk = e & 63;
                T1[dv * 65 + dk] = d[0]; T1[dv * 65 + dk + 1] = d[1]; T1[dv * 65 + dk + 2] = d[2]; T1[dv * 65 + dk + 3] = d[3]; }
            __syncthreads();
            const float* sin = (type == 0 ? P.in[2] : P.in[5]) + (size_t)((j * 128 + b) * 4 + h) * 8192;
            float* sout = P.out + (type == 0 ? O_SC : O_SS) + (size_t)((j * 128 + b) * 4 + h) * 8192;
            const float wl0 = SCAL[i * 4 + 1];
#pragma unroll
            for (int k = 0; k < 4; ++k) { const int e2 = tid * 4 + k * 2048; const int dk = e2 >> 7, dv = e2 & 127; const f32x4 s0 = *(const f32x4*)(sin + e2);
                const float dec = type == 0 ? wl0 : DEC[(size_t)i * 64 + dk]; f32x4 nv;
#pragma unroll
                for (int jj = 0; jj < 4; ++jj) { nv[jj] = dec * s0[jj] + T1[(dv + jj) * 65 + dk]; T2[dk * 129 + dv + jj] = s0[jj]; }
                *(f32x4*)(sout + e2) = nv; }
            __syncthreads();
#pragma unroll
            for (int k = 0; k < 4; ++k) { const int e = tid * 4 + k * 2048; const int dv = e >> 6, dk = e & 63; u32x2 w2;
                w2.x = pk2(T2[dk * 129 + dv], T2[(dk + 1) * 129 + dv]); w2.y = pk2(T2[(dk + 2) * 129 + dv], T2[(dk + 3) * 129 + dv]); *(u32x2*)(CINT + base + e) = w2; }
            if (type == 0 && tid < 64) { const float n0 = P.in[3][(size_t)((j * 128 + b) * 4 + h) * 64 + tid]; NIN[(size_t)i * 64 + tid] = n0;
                P.out[O_SN + (size_t)((j * 128 + b) * 4 + h) * 64 + tid] = wl0 * n0 + DN[(size_t)i * 64 + tid]; }
            __syncthreads();
        }
    }
}

template <int TYPE> __device__ __forceinline__ void ab_out_item(const Params& P, LAS unsigned char* lds, int j, int i) {
    const int tid = otid(), lane = tid & 63, wave = tid >> 6;
    const AbItem it = ab_decode(i);
    const int h = it.h, m0 = it.m0, nvalid = it.nvalid;
    LAS bf16_t* Q = (LAS bf16_t*)lds; LAS bf16_t* Kx = (LAS bf16_t*)(lds + 9216); LAS bf16_t* VT = (LAS bf16_t*)(lds + 18432); LAS bf16_t* C0T = (LAS bf16_t*)(lds + 36864);
    LAS bf16_t* Sw = (LAS bf16_t*)(lds + 55296); LAS float* Ob = (LAS float*)(lds + 64512);
    LAS float* bt = (LAS float*)(lds + 98304); LAS float* igt = bt + 64; LAS float* mt = bt + 128; LAS float* wint = bt + 192; LAS float* rden = bt + 256;
    LAS float* Ac = (LAS float*)(lds + 99840);
    const bf16_t* Pb = (const bf16_t*)(P.ws + WS_P);
    const float* GT = (const float*)(P.ws + WS_GT);
    const int qcol = TYPE == 0 ? h * 64 : 1536 + h * 64, kcol = TYPE == 0 ? 256 + h * 64 : 1792 + h * 64, vcol = TYPE == 0 ? 512 + h * 128 : 2048 + h * 128, gcol = TYPE == 0 ? 1024 + h * 128 : 2560 + h * 128;
    if (TYPE == 0) {
        if (wave == 0) {
            const float igb = P.in[9][j * 4 + h], fgb = P.in[10][j * 4 + h];
            float lf = 0.f, ig = -INFINITY;
            if (lane < nvalid) { lf = logsig(GT[(size_t)(4 + h) * MT + m0 + lane] + fgb); ig = GT[(size_t)h * MT + m0 + lane] + igb; }
            const float bs = wave_scan_add(lf, lane); const float am = wave_scan_max(ig - bs, lane);
            const float mprev = ((const float*)(P.ws + WS_SCAL))[(size_t)i * 4]; const float mtv = bs + fmaxf(mprev, am);
            bt[lane] = bs; igt[lane] = ig; mt[lane] = mtv; wint[lane] = __expf(bs + mprev - mtv);
        }
    } else {
        const float* acg = (const float*)(P.ws + WS_ACUM) + (size_t)i * 4096;
#pragma unroll
        for (int q = 0; q < 8; ++q) { const int idx = tid + q * 512; Ac[(idx >> 6) * 65 + (idx & 63)] = acg[idx]; }
        __syncthreads();
    }
    { const int s = tid >> 3, d8 = (tid & 7) * 8; u32x4 qv = {0u, 0u, 0u, 0u}, kv = {0u, 0u, 0u, 0u};
      if (s < nvalid) { qv = *(const u32x4*)(Pb + (size_t)(m0 + s) * ABN + qcol + d8); kv = *(const u32x4*)(Pb + (size_t)(m0 + s) * ABN + kcol + d8); }
      float qf[8], kf[8];
#pragma unroll
      for (int e = 0; e < 8; ++e) {
          if (TYPE == 0) { qf[e] = bfe(qv, e); kf[e] = bfe(kv, e) * 0.125f; }
          else { const float a = Ac[s * 65 + d8 + e]; qf[e] = bfe(qv, e) * 0.125f * __expf(a); kf[e] = bfe(kv, e) * __expf(-a); } }
      u32x4 qw, kw; qw.x = pk2(qf[0], qf[1]); qw.y = pk2(qf[2], qf[3]); qw.z = pk2(qf[4], qf[5]); qw.w = pk2(qf[6], qf[7]);
      kw.x = pk2(kf[0], kf[1]); kw.y = pk2(kf[2], kf[3]); kw.z = pk2(kf[4], kf[5]); kw.w = pk2(kf[6], kf[7]);
      *(LAS u32x4*)(Q + s * 72 + d8) = qw; *(LAS u32x4*)(Kx + s * 72 + d8) = kw; }
    stage_vt(VT, Pb, m0, vcol, nvalid, tid);
    { const int row = tid >> 2, sg4 = (tid & 3) * 16; const bf16_t* src = (const bf16_t*)(P.ws + WS_CINT) + (size_t)(TYPE * NITEM + i) * 8192 + row * 64 + sg4;
      const u32x4 a = *(const u32x4*)src, b2 = *(const u32x4*)(src + 8); *(LAS u32x4*)(C0T + row * 72 + sg4) = a; *(LAS u32x4*)(C0T + row * 72 + sg4 + 8) = b2; }
    __syncthreads();
    { const int rt = wave >> 1, ct0 = (wave & 1) * 2;
      f32x4 sa[2] = {(f32x4){0.f, 0.f, 0.f, 0.f}, (f32x4){0.f, 0.f, 0.f, 0.f}};
#pragma unroll
      for (int ks = 0; ks < 2; ++ks) { const bf16x8 a = ldsfrag(Q, rt * 16, 72, ks * 32, lane);
#pragma unroll
          for (int jj = 0; jj < 2; ++jj) { const bf16x8 bb = ldsfrag(Kx, (ct0 + jj) * 16, 72, ks * 32, lane); sa[jj] = mma(a, bb, sa[jj]); } }
#pragma unroll
      for (int jj = 0; jj < 2; ++jj)
#pragma unroll
          for (int r = 0; r < 4; ++r) { const int t = rt * 16 + (lane >> 4) * 4 + r, s = (ct0 + jj) * 16 + (lane & 15); float v = 0.f;
              if (s <= t) { v = sa[jj][r]; if (TYPE == 0) v *= __expf(bt[t] - bt[s] + igt[s] - mt[t]); }
              Sw[t * 72 + s] = f2bf(v); } }
    __syncthreads();
    if (TYPE == 0 && tid < 64) {
        const int t = tid; float den = 0.f, qn = 0.f; const float* n0 = (const float*)(P.ws + WS_NIN) + (size_t)i * 64;
        for (int s = 0; s < 64; ++s) { den += bf2f(Sw[t * 72 + s]); qn += bf2f(Q[t * 72 + s]) * n0[s]; }
        den += wint[t] * qn;
        rden[t] = 1.f / fmaxf(fabsf(den), __expf(-mt[t]));
    }
    { const int rt = wave >> 1, ct0 = (wave & 1) * 4;
      f32x4 o[4];
#pragma unroll
      for (int jj = 0; jj < 4; ++jj) o[jj] = (f32x4){0.f, 0.f, 0.f, 0.f};
#pragma unroll
      for (int ks = 0; ks < 2; ++ks) { const bf16x8 a = ldsfrag(Q, rt * 16, 72, ks * 32, lane);
#pragma unroll
          for (int jj = 0; jj < 4; ++jj) { const bf16x8 bb = ldsfrag(C0T, (ct0 + jj) * 16, 72, ks * 32, lane); o[jj] = mma(a, bb, o[jj]); } }
      if (TYPE == 0) {
#pragma unroll
          for (int r = 0; r < 4; ++r) { const float w = wint[rt * 16 + (lane >> 4) * 4 + r];
#pragma unroll
              for (int jj = 0; jj < 4; ++jj) o[jj][r] *= w; } }
#pragma unroll
      for (int ks = 0; ks < 2; ++ks) { const bf16x8 a = ldsfrag(Sw, rt * 16, 72, ks * 32, lane);
#pragma unroll
          for (int jj = 0; jj < 4; ++jj) { const bf16x8 bb = ldsfrag(VT, (ct0 + jj) * 16, 72, ks * 32, lane); o[jj] = mma(a, bb, o[jj]); } }
#pragma unroll
      for (int jj = 0; jj < 4; ++jj)
#pragma unroll
          for (int r = 0; r < 4; ++r) Ob[(rt * 16 + (lane >> 4) * 4 + r) * 132 + (ct0 + jj) * 16 + (lane & 15)] = o[jj][r]; }
    __syncthreads();
    { const float* nrm = (TYPE == 0 ? P.in[11] : P.in[14]) + j * 512 + h * 128;
      const float g0 = nrm[lane], g1 = nrm[lane + 64];
      bf16_t* MIXb = (bf16_t*)(P.ws + WS_MIX);
      for (int rr = 0; rr < 8; ++rr) { const int t = wave * 8 + rr;
          if (t < nvalid) { const float rd = TYPE == 0 ? rden[t] : 1.f;
              const float x0 = Ob[t * 132 + lane] * rd, x1 = Ob[t * 132 + 64 + lane] * rd;
              const float mean = wave_sum(x0 + x1) * (1.f / 128.f); const float d0 = x0 - mean, d1 = x1 - mean;
              const float var = wave_sum(d0 * d0 + d1 * d1) * (1.f / 128.f); const float rs = rsqrtf(var + LN_EPS);
              const bf16_t* gp = Pb + (size_t)(m0 + t) * ABN + gcol; const float p0 = bf2f(gp[lane]), p1 = bf2f(gp[lane + 64]);
              const float ga0 = TYPE == 0 ? sigm(p0) : p0 * sigm(p0), ga1 = TYPE == 0 ? sigm(p1) : p1 * sigm(p1);
              bf16_t* mp = MIXb + (size_t)(m0 + t) * 1024 + TYPE * 512 + h * 128;
              mp[lane] = f2bf(d0 * rs * g0 * ga0); mp[lane + 64] = f2bf(d1 * rs * g1 * ga1); } } }
    __syncthreads();
}

__device__ __forceinline__ void ssd_seq_item(const Params& P, LAS unsigned char* lds, int j, int item) {
    const int tid = otid(), lane = tid & 63, wave = tid >> 6;
    int samp, b, head, base, nchunk, nvalid;
    if (item < 256) { samp = 0; b = item >> 5; head = item & 31; base = b * 2048; nchunk = 32; nvalid = 64; }
    else { const int r = item - 256; samp = 1; b = r >> 5; head = r & 31; base = MP + b * 4; nchunk = 1; nvalid = 4; }
    const int g = head >> 3;
    LAS bf16_t* XT = (LAS bf16_t*)lds; LAS bf16_t* Bm = (LAS bf16_t*)(lds + 9216); LAS bf16_t* BwT = (LAS bf16_t*)(lds + 26624); LAS bf16_t* Cm = (LAS bf16_t*)(lds + 45056);
    LAS bf16_t* H0 = (LAS bf16_t*)(lds + 62464); LAS bf16_t* G = (LAS bf16_t*)(lds + 79872); LAS float* Yb = (LAS float*)(lds + 89088);
    LAS float* dts = (LAS float*)(lds + 106496); LAS float* css = (LAS float*)(lds + 106752);
    const bf16_t* Pb = (const bf16_t*)(P.ws + WS_P);
    const float* GT = (const float*)(P.ws + WS_GT);
    const int pt = wave >> 1, nt0 = (wave & 1) * 4;
    f32x4 hst[4];
    if (samp) { const float* hin = P.in[6] + (size_t)((j * 128 + b) * 32 + head) * 8192;
#pragma unroll
        for (int jj = 0; jj < 4; ++jj)
#pragma unroll
            for (int r = 0; r < 4; ++r) hst[jj][r] = hin[(pt * 16 + (lane >> 4) * 4 + r) * 128 + (nt0 + jj) * 16 + (lane & 15)]; }
    else {
#pragma unroll
        for (int jj = 0; jj < 4; ++jj) hst[jj] = (f32x4){0.f, 0.f, 0.f, 0.f}; }
#pragma unroll
    for (int jj = 0; jj < 4; ++jj)
#pragma unroll
        for (int r = 0; r < 4; ++r) H0[(pt * 16 + (lane >> 4) * 4 + r) * 136 + (nt0 + jj) * 16 + (lane & 15)] = f2bf(hst[jj][r]);
    const float dtb = P.in[19][j * 32 + head], Aneg = -__expf(P.in[20][j * 32 + head]), Dk = P.in[21][j * 32 + head];
    const float* cw = P.in[17] + (size_t)j * 4 * 3072; const float* cb = P.in[18] + (size_t)j * 3072;
    const float* conv0 = P.in[7] + (size_t)(j * 128 + b) * 3 * 3072;
#pragma unroll 1
    for (int c = 0; c < nchunk; ++c) {
        const int m0 = base + c * 64;
        if (wave == 0) { float dt = 0.f; if (lane < nvalid) dt = softplusf(GT[(size_t)head * MT + m0 + lane] + dtb);
            const float cs = wave_scan_add(dt * Aneg, lane); dts[lane] = dt; css[lane] = cs; }
        __syncthreads();
        const float csL = css[63];
#pragma unroll 1
        for (int k = 0; k < 5; ++k) {
            const int task = tid + k * 512, t = task / 40, c8 = task - t * 40;
            const int ch = c8 < 8 ? head * 64 + c8 * 8 : (c8 < 24 ? 2048 + g * 128 + (c8 - 8) * 8 : 2560 + g * 128 + (c8 - 24) * 8);
            float v[8];
#pragma unroll
            for (int e = 0; e < 8; ++e) v[e] = 0.f;
            if (t < nvalid) {
                const f32x4 b0 = *(const f32x4*)(cb + ch), b1 = *(const f32x4*)(cb + ch + 4);
                v[0] = b0[0]; v[1] = b0[1]; v[2] = b0[2]; v[3] = b0[3]; v[4] = b1[0]; v[5] = b1[1]; v[6] = b1[2]; v[7] = b1[3];
#pragma unroll
                for (int w4 = 0; w4 < 4; ++w4) { const int tpos = c * 64 + t - 3 + w4;
                    float raw[8];
                    if (tpos >= 0) { const u32x4 rv = *(const u32x4*)(Pb + (size_t)(base + tpos) * SSDN + 2048 + ch);
#pragma unroll
                        for (int e = 0; e < 8; ++e) raw[e] = bfe(rv, e); }
                    else if (samp) { const float* cp = conv0 + (size_t)(3 + tpos) * 3072 + ch; const f32x4 r0 = *(const f32x4*)cp, r1 = *(const f32x4*)(cp + 4);
                        raw[0] = r0[0]; raw[1] = r0[1]; raw[2] = r0[2]; raw[3] = r0[3]; raw[4] = r1[0]; raw[5] = r1[1]; raw[6] = r1[2]; raw[7] = r1[3]; }
                    else {
#pragma unroll
                        for (int e = 0; e < 8; ++e) raw[e] = 0.f; }
                    const f32x4 w0 = *(const f32x4*)(cw + (size_t)w4 * 3072 + ch), w1 = *(const f32x4*)(cw + (size_t)w4 * 3072 + ch + 4);
                    v[0] += raw[0] * w0[0]; v[1] += raw[1] * w0[1]; v[2] += raw[2] * w0[2]; v[3] += raw[3] * w0[3];
                    v[4] += raw[4] * w1[0]; v[5] += raw[5] * w1[1]; v[6] += raw[6] * w1[2]; v[7] += raw[7] * w1[3]; }
#pragma unroll
                for (int e = 0; e < 8; ++e) v[e] = v[e] * sigm(v[e]);
            }
            if (c8 < 8) {
#pragma unroll
                for (int e = 0; e < 8; ++e) XT[(c8 * 8 + e) * 72 + t] = f2bf(v[e]);
            } else if (c8 < 24) {
                const int n0 = (c8 - 8) * 8; const float wl = __expf(csL - css[t]) * dts[t];
                u32x4 w; w.x = pk2(v[0], v[1]); w.y = pk2(v[2], v[3]); w.z = pk2(v[4], v[5]); w.w = pk2(v[6], v[7]);
                *(LAS u32x4*)(Bm + t * 136 + n0) = w;
#pragma unroll
                for (int e = 0; e < 8; ++e) BwT[(n0 + e) * 72 + t] = f2bf(v[e] * wl);
            } else {
                const int n0 = (c8 - 24) * 8;
                u32x4 w; w.x = pk2(v[0], v[1]); w.y = pk2(v[2], v[3]); w.z = pk2(v[4], v[5]); w.w = pk2(v[6], v[7]);
                *(LAS u32x4*)(Cm + t * 136 + n0) = w;
            }
        }
        __syncthreads();
        { const int rt = wave >> 1, ct0 = (wave & 1) * 2;
          f32x4 ca[2] = {(f32x4){0.f, 0.f, 0.f, 0.f}, (f32x4){0.f, 0.f, 0.f, 0.f}};
#pragma unroll
          for (int ks = 0; ks < 4; ++ks) { const bf16x8 a = ldsfrag(Cm, rt * 16, 136, ks * 32, lane);
#pragma unroll
              for (int jj = 0; jj < 2; ++jj) { const bf16x8 bb = ldsfrag(Bm, (ct0 + jj) * 16, 136, ks * 32, lane); ca[jj] = mma(a, bb, ca[jj]); } }
#pragma unroll
          for (int jj = 0; jj < 2; ++jj)
#pragma unroll
              for (int r = 0; r < 4; ++r) { const int t = rt * 16 + (lane >> 4) * 4 + r, s = (ct0 + jj) * 16 + (lane & 15);
                  const float v = (s <= t) ? ca[jj][r] * __expf(css[t] - css[s]) * dts[s] : 0.f; G[t * 72 + s] = f2bf(v); } }
        __syncthreads();
        { const int rt = wave >> 1, ct0 = (wave & 1) * 2;
          f32x4 y[2] = {(f32x4){0.f, 0.f, 0.f, 0.f}, (f32x4){0.f, 0.f, 0.f, 0.f}};
#pragma unroll
          for (int ks = 0; ks < 4; ++ks) { const bf16x8 a = ldsfrag(Cm, rt * 16, 136, ks * 32, lane);
#pragma unroll
              for (int jj = 0; jj < 2; ++jj) { const bf16x8 bb = ldsfrag(H0, (ct0 + jj) * 16, 136, ks * 32, lane); y[jj] = mma(a, bb, y[jj]); } }
#pragma unroll
          for (int r = 0; r < 4; ++r) { const float w = __expf(css[rt * 16 + (lane >> 4) * 4 + r]); y[0][r] *= w; y[1][r] *= w; }
#pragma unroll
          for (int ks = 0; ks < 2; ++ks) { const bf16x8 a = ldsfrag(G, rt * 16, 72, ks * 32, lane);
#pragma unroll
              for (int jj = 0; jj < 2; ++jj) { const bf16x8 bb = ldsfrag(XT, (ct0 + jj) * 16, 72, ks * 32, lane); y[jj] = mma(a, bb, y[jj]); } }
#pragma unroll
          for (int jj = 0; jj < 2; ++jj)
#pragma unroll
              for (int r = 0; r < 4; ++r) { const int t = rt * 16 + (lane >> 4) * 4 + r, p = (ct0 + jj) * 16 + (lane & 15);
                  Yb[t * 68 + p] = y[jj][r] + Dk * bf2f(XT[p * 72 + t]); } }
        { const float dec = __expf(csL);
#pragma unroll
          for (int jj = 0; jj < 4; ++jj) hst[jj] = hst[jj] * dec;
#pragma unroll
          for (int ks = 0; ks < 2; ++ks) { const bf16x8 a = ldsfrag(XT, pt * 16, 72, ks * 32, lane);
#pragma unroll
              for (int jj = 0; jj < 4; ++jj) { const bf16x8 bb = ldsfrag(BwT, (nt0 + jj) * 16, 72, ks * 32, lane); hst[jj] = mma(a, bb, hst[jj]); } } }
        __syncthreads();
#pragma unroll
        for (int jj = 0; jj < 4; ++jj)
#pragma unroll
            for (int r = 0; r < 4; ++r) H0[(pt * 16 + (lane >> 4) * 4 + r) * 136 + (nt0 + jj) * 16 + (lane & 15)] = f2bf(hst[jj][r]);
        { bf16_t* YG = (bf16_t*)(P.ws + WS_YG); float* SQ = (float*)(P.ws + WS_SQ);
          for (int rr = 0; rr < 8; ++rr) { const int t = wave * 8 + rr;
              if (t < nvalid) { const float z = bf2f(Pb[(size_t)(m0 + t) * SSDN + head * 64 + lane]); const float yg = Yb[t * 68 + lane] * (z * sigm(z));
                  YG[(size_t)(m0 + t) * 2048 + head * 64 + lane] = f2bf(yg); const float sq = wave_sum(yg * yg);
                  if (lane == 0) SQ[(size_t)(m0 + t) * 32 + head] = sq; } } }
    }
    { float* hout = P.out + (samp ? O_SH + (size_t)((j * 128 + b) * 32 + head) * 8192 : O_PH + (size_t)((j * 8 + b) * 32 + head) * 8192);
#pragma unroll
      for (int jj = 0; jj < 4; ++jj)
#pragma unroll
          for (int r = 0; r < 4; ++r) hout[(pt * 16 + (lane >> 4) * 4 + r) * 128 + (nt0 + jj) * 16 + (lane & 15)] = hst[jj][r]; }
    __syncthreads();
}

__device__ __forceinline__ void ssd_norm_phase(const Params& P, int j) {
    const int gtid = blockIdx.x * 512 + otid(), gsz = gridDim.x * 512;
    const bf16_t* YG = (const bf16_t*)(P.ws + WS_YG); const float* SQ = (const float*)(P.ws + WS_SQ); bf16_t* MIXb = (bf16_t*)(P.ws + WS_MIX);
    const float* ng = P.in[22] + (size_t)j * 2048;
    for (int idx = gtid; idx < MT * 256; idx += gsz) {
        const int m = idx >> 8, c8 = idx & 255, g = c8 >> 6;
        const f32x4 s0 = *(const f32x4*)(SQ + (size_t)m * 32 + g * 8), s1 = *(const f32x4*)(SQ + (size_t)m * 32 + g * 8 + 4);
        const float ss = ((s0[0] + s0[1]) + (s0[2] + s0[3])) + ((s1[0] + s1[1]) + (s1[2] + s1[3]));
        const float sc = rsqrtf(ss * (1.f / 512.f) + LN_EPS);
        const u32x4 yv = *(const u32x4*)(YG + (size_t)m * 2048 + c8 * 8);
        const f32x4 g0 = *(const f32x4*)(ng + c8 * 8), g1 = *(const f32x4*)(ng + c8 * 8 + 4);
        u32x4 w; w.x = pk2(bfe(yv, 0) * sc * g0[0], bfe(yv, 1) * sc * g0[1]); w.y = pk2(bfe(yv, 2) * sc * g0[2], bfe(yv, 3) * sc * g0[3]);
        w.z = pk2(bfe(yv, 4) * sc * g1[0], bfe(yv, 5) * sc * g1[1]); w.w = pk2(bfe(yv, 6) * sc * g1[2], bfe(yv, 7) * sc * g1[3]);
        *(u32x4*)(MIXb + (size_t)m * 2048 + c8 * 8) = w;
    }
    const bf16_t* Pb = (const bf16_t*)(P.ws + WS_P);
    for (int idx = gtid; idx < (8 + 128) * 3 * 3072; idx += gsz) {
        const int ch = idx % 3072, rw = idx / 3072, w = rw % 3, bb = rw / 3;
        if (bb < 8) P.out[O_PCV + ((size_t)(j * 8 + bb) * 3 + w) * 3072 + ch] = bf2f(Pb[(size_t)(bb * 2048 + 2045 + w) * SSDN + 2048 + ch]);
        else { const int b = bb - 8; P.out[O_SCV + ((size_t)(j * 128 + b) * 3 + w) * 3072 + ch] = bf2f(Pb[(size_t)(MP + b * 4 + 1 + w) * SSDN + 2048 + ch]); }
    }
}

__global__ void __launch_bounds__(512) mega_fwd(Params P) {
    extern __shared__ __attribute__((aligned(16))) unsigned char smem[];
    LAS unsigned char* lds = (LAS unsigned char*)smem;
    const int tid = otid();
    volatile LAS unsigned* bst = (volatile LAS unsigned*)(lds + LDS_BAR_OFF);
    if (tid < 64) bst[tid] = 0u;
    __syncthreads();
    XcdBarrier bar = xcd_barrier_post((unsigned*)(P.ws + WS_CTL), bst);
    cg::grid_group grid = cg::this_grid();
#define GRID_BAR() xcd_barrier(bar)

#ifndef SKIP_P0
    p0_prologue(P, lds);
#endif
    grid.sync();

    const bf16_t* XB = (const bf16_t*)(P.ws + WS_XB); float* XF = (float*)(P.ws + WS_XF); float* Y = (float*)(P.ws + WS_Y);
    bf16_t* Pb = (bf16_t*)(P.ws + WS_P); bf16_t* MIXb = (bf16_t*)(P.ws + WS_MIX); float* GT = (float*)(P.ws + WS_GT);
#pragma unroll 1
    for (int l = 0; l < 4; ++l) {
        const int j = l >> 1, ssd = l & 1;
        { const bf16_t* Bt = ssd ? (const bf16_t*)(P.ws + WS_WSSDIN) + (size_t)j * SSDN * 1024 : (const bf16_t*)(P.ws + WS_WABIN) + (size_t)j * ABN * 1024;
          const int N = ssd ? SSDN : ABN;
          pg8::Gemm g{XB, Bt, MT, N, 1024}; pg8::StaticOrder S; S.init(MT, N, gridDim.x, blockIdx.x);
          pg8::EpiB<0> E{Pb, N};
#ifndef SKIP_G1
          pg8::gemm_phase<pg8::EpiB<0>, pg8::StaticOrder>(lds, g, S, E, nullptr);
#endif
#ifndef SKIP_GATES
          gates_phase(XB, ssd ? (const bf16_t*)(P.ws + WS_WSSDG) + (size_t)j * 32768 : (const bf16_t*)(P.ws + WS_WABG) + (size_t)j * 32768, GT);
#endif
 }
        GRID_BAR();
        if (!ssd) {
#ifndef SKIP_A2
            for (int w = blockIdx.x; w < 2 * NITEM; w += gridDim.x) { if (w < NITEM) ab_delta_item<0>(P, lds, j, w); else ab_delta_item<1>(P, lds, j, w - NITEM); }
#endif
            GRID_BAR();
#ifndef SKIP_A3
            ab_scan_phase(P, lds, j);
#endif
            GRID_BAR();
#ifndef SKIP_A4
            for (int w = blockIdx.x; w < 2 * NITEM; w += gridDim.x) { if (w < NITEM) ab_out_item<0>(P, lds, j, w); else ab_out_item<1>(P, lds, j, w - NITEM); }
#endif
            GRID_BAR();
        } else {
#ifndef SKIP_S2
            for (int w = blockIdx.x; w < 256 + 4096; w += gridDim.x) ssd_seq_item(P, lds, j, w);
#endif
            GRID_BAR();
#ifndef SKIP_S3
            ssd_norm_phase(P, j);
#endif
            GRID_BAR();
        }
        { const bf16_t* Bt = ssd ? (const bf16_t*)(P.ws + WS_WSSDOUT) + (size_t)j * 1024 * 2048 : (const bf16_t*)(P.ws + WS_WABOUT) + (size_t)j * 1024 * 1024;
          const int K = ssd ? 2048 : 1024;
          pg8::Gemm g{MIXb, Bt, MT, 1024, K}; pg8::StaticOrder S; S.init(MT, 1024, gridDim.x, blockIdx.x);
          pg8::EpiRes E{XF, Y, 1024, DN_ALPHA};
#ifndef SKIP_G2
          pg8::gemm_phase<pg8::EpiRes, pg8::StaticOrder>(lds, g, S, E, nullptr);
#endif
 }
        GRID_BAR();
        ln_phase(Y, P.in[26] + (size_t)l * 1024, P.in[27] + (size_t)l * 1024, XF, (bf16_t*)(P.ws + WS_XB));
        GRID_BAR();
        { pg8::Gemm g{XB, (const bf16_t*)(P.ws + WS_W1) + (size_t)l * 4096 * 1024, MT, DFF, 1024}; pg8::StaticOrder S; S.init(MT, DFF, gridDim.x, blockIdx.x);
          pg8::EpiB<1> E{Pb, DFF};
#ifndef SKIP_G3
          pg8::gemm_phase<pg8::EpiB<1>, pg8::StaticOrder>(lds, g, S, E, nullptr);
#endif
 }
        GRID_BAR();
        { pg8::Gemm g{Pb, (const bf16_t*)(P.ws + WS_W2) + (size_t)l * 1024 * 4096, MT, 1024, DFF}; pg8::StaticOrder S; S.init(MT, 1024, gridDim.x, blockIdx.x);
          pg8::EpiRes E{XF, Y, 1024, DN_ALPHA};
#ifndef SKIP_G4
          pg8::gemm_phase<pg8::EpiRes, pg8::StaticOrder>(lds, g, S, E, nullptr);
#endif
 }
        GRID_BAR();
        ln_phase(Y, P.in[28] + (size_t)l * 1024, P.in[29] + (size_t)l * 1024, l == 3 ? P.out : XF, (bf16_t*)(P.ws + WS_XB));
        if (l < 3) GRID_BAR();
    }
}

extern "C" void kernel_launch(void* const* d_in, const int* in_sizes, int n_in, void* d_out, int out_size, void* d_ws, size_t ws_size, hipStream_t stream) {
    static int grid = 0;
    if (grid == 0) {
        if (n_in != 30 || (size_t)out_size != O_END || ws_size < WS_END) { fprintf(stderr, "kernel_launch: unexpected shapes (n_in %d, out %d, ws %zu)\n", n_in, out_size, ws_size); grid = -1; return; }
        int dev = 0, cus = 0, per_cu = 0;
        (void)hipGetDevice(&dev); (void)hipDeviceGetAttribute(&cus, hipDeviceAttributeMultiprocessorCount, dev);
        (void)hipFuncSetAttribute((const void*)mega_fwd, hipFuncAttributeMaxDynamicSharedMemorySize, LDS_BYTES);
        (void)hipOccupancyMaxActiveBlocksPerMultiprocessor(&per_cu, (const void*)mega_fwd, 512, LDS_BYTES);
        if (per_cu < 1) { fprintf(stderr, "kernel_launch: occupancy query says %d blocks per CU\n", per_cu); per_cu = 1; }
        grid = cus * per_cu; if (grid > 256) grid = 256;
        (void)hipGetLastError();
    }
    if (grid < 0) return;
    (void)hipMemsetAsync((char*)d_ws + WS_CTL, 0, CTL_BYTES, stream);
    Params p{};
    for (int i = 0; i < 30; ++i) p.in[i] = (const float*)d_in[i];
    p.out = (float*)d_out; p.ws = (unsigned char*)d_ws;
    void* args[] = {&p};
    hipError_t e = hipLaunchCooperativeKernel((const void*)mega_fwd, dim3(grid), dim3(512), args, LDS_BYTES, stream);
    if (e != hipSuccess) fprintf(stderr, "kernel_launch: cooperative launch failed: %s (grid %d)\n", hipGetErrorString(e), grid);
}
```

```cpp
#include <hip/hip_runtime.h>
#include <hip/hip_cooperative_groups.h>
#include <cstdio>
namespace cg = cooperative_groups;

namespace pg8 {
#define PG8_LAS __attribute__((address_space(3)))
typedef unsigned short bf16_t;
typedef short bf16x8 __attribute__((ext_vector_type(8)));
typedef float f32x4 __attribute__((ext_vector_type(4)));
typedef unsigned u32x4 __attribute__((ext_vector_type(4)));
constexpr int BM = 256, BK = 64, HALF = 128, HTB = HALF * BK * 2  , STAGE_BYTES = 8 * HTB, NXCD = 8, WGM = 8;

__host__ __device__ __forceinline__ int lds_byte(int r, int c) { const int st = (r >> 4) * 2 + (c >> 5), rr = r & 15, cc = c & 31, ob = rr * 64 + cc * 2; return st * 1024 + (ob ^ (((ob >> 9) & 1) << 5)); }
__host__ __device__ __forceinline__ void stage_rc(int b, int& R, int& C) { const int st = b / 1024, sb = b % 1024, swz = sb ^ (((sb >> 9) & 1) << 5); R = (st >> 1) * 16 + swz / 64; C = (st & 1) * 32 + (swz % 64) / 2; }
__host__ __device__ __forceinline__ int perm32(int rho) { const int n = rho >> 4, i = rho & 15; return 8 * (i >> 2) + 4 * n + (i & 3); }

struct Unit { int pm, pn; };
struct Gemm { const bf16_t* A; const bf16_t* Bt; int M, N, K; };

struct StaticOrder {
    int nM, nN, nwg, G, c;
    __host__ __device__ void init(int M, int N, int G_, int c_) { nM = M / BM; nN = N / BM; nwg = nM * nN; G = G_; c = c_; }
    __host__ __device__ bool next(int i, Unit& u) const {
        const long L = (long)i * G + c; if (L >= nwg) return false;
        int wgid = (int)L; { const int q = nwg / NXCD, r = nwg % NXCD, xcd = wgid % NXCD, off = wgid / NXCD; wgid = (xcd < r ? xcd * (q + 1) : r * (q + 1) + (xcd - r) * q) + off; }
        const int nig = WGM * nN, gid = wgid / nig, fm = gid * WGM, gsz = (nM - fm) < WGM ? (nM - fm) : WGM;
        u.pm = fm + ((wgid % nig) % gsz); u.pn = (wgid % nig) / gsz; return true;
    }
    __device__ __forceinline__ void a_ready(const Unit&) const {}
    __device__ __forceinline__ void done(const Unit&) const {}
};
__device__ __forceinline__ unsigned cvt_pk_bf16(float lo, float hi) { unsigned r; asm volatile("v_cvt_pk_bf16_f32 %0, %1, %2" : "=v"(r) : "v"(lo), "v"(hi)); return r; }

template <int ACT  > struct EpiB {
    static constexpr bool PERM = true, AFTER_DRAIN = false;
    bf16_t* O; int ldc;
    __device__ __forceinline__ void operator()(const f32x4 (&acc)[2][2][4][2], const Unit& u, int wr, int wc, int fr, int fq) const {
        const int row0 = u.pm * BM + wr * 64 + fr, col0 = u.pn * BM + wc * 32 + 8 * fq;
#pragma unroll
        for (int ai = 0; ai < 2; ++ai)
#pragma unroll
            for (int m = 0; m < 4; ++m) { bf16_t* rowp = O + (size_t)(row0 + ai * HALF + m * 16) * ldc + col0;
#pragma unroll
                for (int bj = 0; bj < 2; ++bj) { f32x4 v0 = acc[ai][bj][m][0], v1 = acc[ai][bj][m][1];
                    if (ACT == 1) {
#pragma unroll
                        for (int q = 0; q < 4; ++q) { const float a = fmaxf(v0[q], 0.f), b = fmaxf(v1[q], 0.f); v0[q] = a * a; v1[q] = b * b; } }
                    u32x4 w; w.x = cvt_pk_bf16(v0[0], v0[1]); w.y = cvt_pk_bf16(v0[2], v0[3]); w.z = cvt_pk_bf16(v1[0], v1[1]); w.w = cvt_pk_bf16(v1[2], v1[3]);
                    *(u32x4*)(rowp + bj * HALF) = w; } }
    }
};
struct EpiRes {
    static constexpr bool PERM = true, AFTER_DRAIN = false;
    const bf16_t* X; bf16_t* Y; int ldc; float alpha;
    __device__ __forceinline__ void operator()(const f32x4 (&acc)[2][2][4][2], const Unit& u, int wr, int wc, int fr, int fq) const {
        const int row0 = u.pm * BM + wr * 64 + fr, col0 = u.pn * BM + wc * 32 + 8 * fq;
#pragma unroll
        for (int ai = 0; ai < 2; ++ai)
#pragma unroll
            for (int m = 0; m < 4; ++m) { const size_t off = (size_t)(row0 + ai * HALF + m * 16) * ldc + col0;
#pragma unroll
                for (int bj = 0; bj < 2; ++bj) { const u32x4 x = *(const u32x4*)(X + off + bj * HALF); const f32x4 v0 = acc[ai][bj][m][0], v1 = acc[ai][bj][m][1];
                    u32x4 w;
                    w.x = cvt_pk_bf16(v0[0] + alpha * __uint_as_float(x.x << 16), v0[1] + alpha * __uint_as_float(x.x & 0xffff0000u));
                    w.y = cvt_pk_bf16(v0[2] + alpha * __uint_as_float(x.y << 16), v0[3] + alpha * __uint_as_float(x.y & 0xffff0000u));
                    w.z = cvt_pk_bf16(v1[0] + alpha * __uint_as_float(x.z << 16), v1[1] + alpha * __uint_as_float(x.z & 0xffff0000u));
                    w.w = cvt_pk_bf16(v1[2] + alpha * __uint_as_float(x.w << 16), v1[3] + alpha * __uint_as_float(x.w & 0xffff0000u));
                    *(u32x4*)(Y + off + bj * HALF) = w; }
                asm volatile("" ::: "memory"); }
    }
};

template <class Epi, class Sched, bool STAMP = false>
__device__ __forceinline__ void gemm_phase(PG8_LAS unsigned char* lds, const Gemm g, const Sched& S, const Epi& E, unsigned long long* stamps) {
    int tid_o = threadIdx.x; asm volatile("" : "+v"(tid_o)); const int tid = tid_o, wid = __builtin_amdgcn_readfirstlane(tid >> 6), lane = tid & 63, wr = wid >> 2, wc = wid & 3, fr = lane & 15, fq = lane >> 4;
    const int K = g.K, nt = K / BK;
    int ts_lo = 0, ts_hi = 0, nts = 0; const unsigned long long rt_entry = STAMP ? (unsigned long long)wall_clock64() : 0ull;
#define PG8_STAMP() do { if (STAMP && wid == 0 && nts < 64) { const unsigned long long _c = (unsigned long long)clock64(); \
        ts_lo = (lane == nts) ? (int)(unsigned)_c : ts_lo; ts_hi = (lane == nts) ? (int)(unsigned)(_c >> 32) : ts_hi; ++nts; } } while (0)
    PG8_STAMP();
    unsigned voffA[2], voffB[2];
#pragma unroll
    for (int i = 0; i < 2; ++i) { int R, C; stage_rc(tid * 16 + i * 8192, R, C); const int Rb = Epi::PERM ? ((R & ~31) + perm32(R & 31)) : R;
        voffA[i] = (unsigned)(R * K + C) * 2u; voffB[i] = (unsigned)(Rb * K + C) * 2u; }
    const size_t kstep = (size_t)(BK * 2);
    const size_t hstep = (size_t)HALF * K * 2;
    const size_t tstep = 2 * hstep;
    const unsigned ldsw = (unsigned)wid * 1024u;
    const int aoff = lds_byte(wr * 64 + fr, fq * 8), boff = lds_byte(wc * 32 + fr, fq * 8);
#define PG8_SA(b, h) (((b) * 2 + (h)) * HTB)
#define PG8_SB(b, h) ((4 + (b) * 2 + (h)) * HTB)
#define PG8_STAGE(bufoff, gbase, voff) do { _Pragma("unroll") for (int _i = 0; _i < 2; ++_i) \
        __builtin_amdgcn_global_load_lds((const unsigned*)((const char*)(gbase) + (voff)[_i]), (PG8_LAS unsigned*)(lds + (bufoff) + ldsw + _i * 8192), 16, 0, 0); } while (0)
#define PG8_LDA(dst, b, h) do { _Pragma("unroll") for (int m = 0; m < 4; ++m) _Pragma("unroll") for (int k = 0; k < 2; ++k) dst[m][k] = *(const PG8_LAS bf16x8*)(lds + PG8_SA(b, h) + aoff + m * 2048 + k * 1024); } while (0)
#define PG8_LDB(dst, b, h) do { _Pragma("unroll") for (int n = 0; n < 2; ++n) _Pragma("unroll") for (int k = 0; k < 2; ++k) dst[n][k] = *(const PG8_LAS bf16x8*)(lds + PG8_SB(b, h) + boff + n * 2048 + k * 1024); } while (0)
#define PG8_MMA(ai, bj, At, Bt) do { __builtin_amdgcn_s_setprio(1); _Pragma("unroll") for (int m = 0; m < 4; ++m) _Pragma("unroll") for (int n = 0; n < 2; ++n) _Pragma("unroll") for (int k = 0; k < 2; ++k) \
        acc[ai][bj][m][n] = __builtin_amdgcn_mfma_f32_16x16x32_bf16(Bt[n][k], At[m][k], acc[ai][bj][m][n], 0, 0, 0); __builtin_amdgcn_s_setprio(0); } while (0)
#define PG8_WAIT_V(n) asm volatile("s_waitcnt vmcnt(" #n ")" ::: "memory")
#define PG8_WAIT_L(n) asm volatile("s_waitcnt lgkmcnt(" #n ")" ::: "memory")
#define PG8_BAR __builtin_amdgcn_s_barrier()
#define PG8_SCHED __builtin_amdgcn_sched_barrier(0)
    Unit cur, nxt; int ui = 0;
    if (!S.next(0, cur)) return;
    f32x4 acc[2][2][4][2];
#pragma unroll
    for (int a = 0; a < 2; ++a)
#pragma unroll
        for (int b = 0; b < 2; ++b)
#pragma unroll
            for (int m = 0; m < 4; ++m)
#pragma unroll
                for (int n = 0; n < 2; ++n) acc[a][b][m][n] = (f32x4){0.f, 0.f, 0.f, 0.f};
    bf16x8 At[4][2], B0[2][2], B1[2][2];
    const char* cA = (const char*)g.A + (size_t)cur.pm * tstep; const char* cB = (const char*)g.Bt + (size_t)cur.pn * tstep;
    S.a_ready(cur);
    PG8_STAGE(PG8_SB(0, 0), cB, voffB); PG8_STAGE(PG8_SA(0, 0), cA, voffA); PG8_STAGE(PG8_SB(0, 1), cB + hstep, voffB); PG8_STAGE(PG8_SA(0, 1), cA + hstep, voffA);
    if (wr == 1) PG8_BAR;
    PG8_WAIT_V(4); PG8_BAR;
    PG8_STAGE(PG8_SB(1, 0), cB + kstep, voffB); PG8_STAGE(PG8_SA(1, 0), cA + kstep, voffA); PG8_STAGE(PG8_SB(1, 1), cB + hstep + kstep, voffB);
    PG8_WAIT_V(6); PG8_BAR;
    PG8_STAMP();
    for (;;) {
        const bool has_next = S.next(ui + 1, nxt);
        const char* nA = has_next ? (const char*)g.A + (size_t)nxt.pm * tstep : cA; const char* nB = has_next ? (const char*)g.Bt + (size_t)nxt.pn * tstep : cB;
        for (int t = 0; t < nt; t += 2) {
            const bool last = (t == nt - 2);
            const char* a1 = cA + (size_t)(t + 1) * kstep;
            const char* a2 = last ? nA : cA + (size_t)(t + 2) * kstep; const char* b2 = last ? nB : cB + (size_t)(t + 2) * kstep;
            const char* a3 = a2 + kstep; const char* b3 = b2 + kstep;
            if (last && has_next) S.a_ready(nxt);
            PG8_LDB(B0, 0, 0); PG8_SCHED; PG8_LDA(At, 0, 0); PG8_STAGE(PG8_SA(1, 1), a1 + hstep, voffA);
            PG8_WAIT_L(8); PG8_BAR; PG8_WAIT_L(0); PG8_MMA(0, 0, At, B0); PG8_BAR; PG8_SCHED;
            PG8_LDB(B1, 0, 1); PG8_STAGE(PG8_SB(0, 0), b2, voffB);
            PG8_BAR; PG8_WAIT_L(0); PG8_MMA(0, 1, At, B1); PG8_BAR;
            PG8_LDA(At, 0, 1); PG8_STAGE(PG8_SA(0, 0), a2, voffA);
            PG8_BAR; PG8_WAIT_L(0); PG8_MMA(1, 0, At, B0); PG8_BAR; PG8_SCHED;
            PG8_STAGE(PG8_SB(0, 1), b2 + hstep, voffB);
            PG8_WAIT_V(6); PG8_BAR; PG8_MMA(1, 1, At, B1); PG8_BAR;
            PG8_LDB(B0, 1, 0); PG8_SCHED; PG8_LDA(At, 1, 0); PG8_STAGE(PG8_SA(0, 1), a2 + hstep, voffA);
            PG8_WAIT_L(8); PG8_BAR; PG8_WAIT_L(0); PG8_MMA(0, 0, At, B0); PG8_BAR; PG8_SCHED;
            PG8_LDB(B1, 1, 1); PG8_STAGE(PG8_SB(1, 0), b3, voffB);
            PG8_BAR; PG8_WAIT_L(0); PG8_MMA(0, 1, At, B1); PG8_BAR;
            PG8_LDA(At, 1, 1); PG8_STAGE(PG8_SA(1, 0), a3, voffA);
            PG8_BAR; PG8_WAIT_L(0); PG8_MMA(1, 0, At, B0); PG8_BAR; PG8_SCHED;
            PG8_STAGE(PG8_SB(1, 1), b3 + hstep, voffB);
            PG8_WAIT_V(6); PG8_BAR; PG8_MMA(1, 1, At, B1); PG8_BAR;
        }
        PG8_STAMP();
        if constexpr (!Epi::AFTER_DRAIN) { E(acc, cur, wr, wc, fr, fq); S.done(cur); }
        PG8_STAMP();
        if (!has_next) break;
#pragma unroll
        for (int a = 0; a < 2; ++a)
#pragma unroll
            for (int b = 0; b < 2; ++b)
#pragma unroll
                for (int m = 0; m < 4; ++m)
#pragma unroll
                    for (int n = 0; n < 2; ++n) acc[a][b][m][n] = (f32x4){0.f, 0.f, 0.f, 0.f};
        cur = nxt; cA = nA; cB = nB; ++ui;
    }
    PG8_WAIT_V(0);
    if (wr == 0) PG8_BAR;
    PG8_BAR;
    if constexpr (Epi::AFTER_DRAIN) { E.fused(acc, cur, wr, wc, fr, fq, lds, wid, lane); S.done(cur); }
    PG8_STAMP();
    if (STAMP && wid == 0) { stamps[lane] = lane < nts ? (((unsigned long long)(unsigned)ts_hi << 32) | (unsigned)ts_lo) : 0ull;
        if (lane == 62) stamps[62] = rt_entry; if (lane == 63) stamps[63] = (unsigned long long)wall_clock64(); }
#undef PG8_STAMP
#undef PG8_SA
#undef PG8_SB
#undef PG8_STAGE
#undef PG8_LDA
#undef PG8_LDB
#undef PG8_MMA
#undef PG8_WAIT_V
#undef PG8_WAIT_L
#undef PG8_BAR
#undef PG8_SCHED
}
}

#define LAS __attribute__((address_space(3)))
typedef unsigned short bf16_t;
typedef short bf16x8 __attribute__((ext_vector_type(8)));
typedef float f32x4 __attribute__((ext_vector_type(4)));
typedef unsigned u32x4 __attribute__((ext_vector_type(4)));
typedef unsigned u32x2 __attribute__((ext_vector_type(2)));

constexpr int MP = 16384, MS = 512, MT = MP + MS;
constexpr int DM = 1024, DFF = 4096;
constexpr int ABN = 3072, ABSRC = 3096, SSDN = 5120, SSDSRC = 5152;
constexpr int NITEM = 1536;
constexpr float LN_EPS = 1e-5f;
constexpr float DN_ALPHA = 1.6817928305074290861f;

constexpr size_t MiB = (size_t)1 << 20;
constexpr size_t WS_CTL = 0, CTL_BYTES = 16384;
constexpr size_t WS_WABIN = 1 * MiB, WS_WABG = 13 * MiB, WS_WABOUT = 14 * MiB, WS_WSSDIN = 18 * MiB, WS_WSSDG = 38 * MiB, WS_WSSDOUT = 39 * MiB;
constexpr size_t WS_W1 = 47 * MiB, WS_W2 = 79 * MiB;
constexpr size_t WS_XF = 112 * MiB, WS_XB = 178 * MiB, WS_Y = 211 * MiB, WS_P = 277 * MiB  , WS_MIX = 442 * MiB, WS_YG = 508 * MiB;
constexpr size_t WS_GT = 574 * MiB, WS_SQ = 577 * MiB, WS_DCT = 580 * MiB, WS_CINT = 676 * MiB, WS_ACUM = 724 * MiB, WS_DN = 748 * MiB, WS_NIN = 749 * MiB, WS_DEC = 750 * MiB, WS_SCAL = 751 * MiB;
constexpr size_t WS_CONVB = WS_DCT;
constexpr size_t WS_CS = 752 * MiB;
constexpr size_t WS_DTB = 756 * MiB;
constexpr size_t WS_END = 760 * MiB;

constexpr size_t O_YP = 0, O_YS = 16777216, O_PC = O_YS + 524288, O_PN = O_PC + 524288, O_PM = O_PN + 4096, O_PS = O_PM + 64, O_PH = O_PS + 524288, O_PCV = O_PH + 4194304;
constexpr size_t O_SC = O_PCV + 147456, O_SN = O_SC + 8388608, O_SM = O_SN + 65536, O_SS = O_SM + 1024, O_SH = O_SS + 8388608, O_SCV = O_SH + 67108864, O_END = O_SCV + 2359296;

constexpr int LDS_BAR_OFF = 156672, LDS_BYTES = 156672 + 256;

struct Params { const float* in[30]; float* out; unsigned char* ws; };

#define RAW_BAR() do { asm volatile("s_waitcnt lgkmcnt(0)" ::: "memory"); __builtin_amdgcn_s_barrier(); asm volatile("" ::: "memory"); } while (0)
__device__ __forceinline__ int otid() { int t = threadIdx.x; asm volatile("" : "+v"(t)); return t; }
__device__ __forceinline__ float bf2f(bf16_t v) { return __uint_as_float(((unsigned)v) << 16); }
__device__ __forceinline__ unsigned pk2(float lo, float hi) { unsigned r; asm("v_cvt_pk_bf16_f32 %0, %1, %2" : "=v"(r) : "v"(lo), "v"(hi)); return r; }
__device__ __forceinline__ bf16_t f2bf(float f) { return (bf16_t)(pk2(f, f) & 0xffffu); }
__device__ __forceinline__ float bfe(const u32x4& v, int e) { const unsigned w = v[e >> 1]; return __uint_as_float((e & 1) ? (w & 0xffff0000u) : (w << 16)); }
__device__ __forceinline__ bf16_t bfr(const u32x4& v, int e) { const unsigned w = v[e >> 1]; return (bf16_t)((e & 1) ? (w >> 16) : (w & 0xffffu)); }
__device__ __forceinline__ float logsig(float x) { return fminf(x, 0.f) - log1pf(__expf(-fabsf(x))); }
__device__ __forceinline__ float softplusf(float x) { return fmaxf(x, 0.f) + log1pf(__expf(-fabsf(x))); }
__device__ __forceinline__ float sigm(float x) { return __builtin_amdgcn_rcpf(1.f + __expf(-x)); }
__device__ __forceinline__ float wave_sum(float v) {
#pragma unroll
    for (int o = 32; o >= 1; o >>= 1) v += __shfl_xor(v, o);
    return v; }
__device__ __forceinline__ float wave_max(float v) {
#pragma unroll
    for (int o = 32; o >= 1; o >>= 1) v = fmaxf(v, __shfl_xor(v, o));
    return v; }
__device__ __forceinline__ float wave_scan_add(float v, int lane) {
#pragma unroll
    for (int o = 1; o < 64; o <<= 1) { const float t = __shfl_up(v, o); if (lane >= o) v += t; }
    return v; }
__device__ __forceinline__ float wave_scan_max(float v, int lane) {
#pragma unroll
    for (int o = 1; o < 64; o <<= 1) { const float t = __shfl_up(v, o); if (lane >= o) v = fmaxf(v, t); }
    return v; }
__device__ __forceinline__ f32x4 mma(bf16x8 a, bf16x8 b, f32x4 c) { return __builtin_amdgcn_mfma_f32_16x16x32_bf16(a, b, c, 0, 0, 0); }
__device__ __forceinline__ bf16x8 ldsfrag(const LAS bf16_t* base, int row0, int ld, int k0, int lane) {
    return *(const LAS bf16x8*)(base + (row0 + (lane & 15)) * ld + k0 + (lane >> 4) * 8); }

__device__ __forceinline__ bf16x8 ldsfrag_swz(const LAS bf16_t* base, int row0, int ld, int k0, int lane) {
    const int row = row0 + (lane & 15), k = k0 + (lane >> 4) * 8;
    return *(const LAS bf16x8*)(base + row * ld + (k ^ (((row >> 3) & 7) << 3))); }

#define XB_TMO      128
#define XB_XCNT(j)  (256  + 64 * (j))
#define XB_XSUB(j)  (1280 + 64 * (j))
#define XB_XGEN(j)  (2304 + 64 * (j))
#define XB_TOP      3328
#define XB_TOPGEN   3392
#define XCD_BAR_WORDS 3456
#define XB_SPIN_CAP (1u << 18)
__device__ __forceinline__ unsigned xb_ld(unsigned* p)              { return __hip_atomic_load(p, __ATOMIC_RELAXED, __HIP_MEMORY_SCOPE_AGENT); }
__device__ __forceinline__ unsigned xb_add(unsigned* p, unsigned v) { return __hip_atomic_fetch_add(p, v, __ATOMIC_RELAXED, __HIP_MEMORY_SCOPE_AGENT); }
__device__ __forceinline__ unsigned xb_xcc_id() { return (unsigned)__builtin_amdgcn_s_getreg((3 << 11) | 20) & 0xFu; }
#define XB_SPIN(cond, bar) do { unsigned _sp = 0; while (cond) { __builtin_amdgcn_s_sleep(1); \
    if ((++_sp & 255u) == 0u) { if (xb_ld(&(bar)[XB_TMO])) break; if (_sp > XB_SPIN_CAP) { atomicAdd(&(bar)[XB_TMO], 1u); break; } } } } while (0)
struct XcdBarrier { unsigned* bar; unsigned x; volatile LAS unsigned* st; };
__device__ __forceinline__ XcdBarrier xcd_barrier_post(unsigned* bar, volatile LAS unsigned* st) {
    XcdBarrier b; b.bar = bar; b.x = xb_xcc_id(); b.st = st;
    if (threadIdx.x == 0) (void)xb_add(&bar[XB_XCNT(b.x)], 1u);
    return b;
}
__device__ __forceinline__ void xcd_barrier_complete(unsigned* bar, unsigned x, unsigned& nloc, unsigned& nx) {
    const unsigned G = gridDim.x * gridDim.y * gridDim.z;
    unsigned sum, cnt, mine, sp = 0u;
    for (;;) {
        sum = 0u; cnt = 0u; mine = 0u;
#pragma unroll
        for (unsigned j = 0; j < 16; ++j) { const unsigned c = xb_ld(&bar[XB_XCNT(j)]); sum += c; cnt += (c > 0u) ? 1u : 0u; mine = (j == x) ? c : mine; }
        if (sum == G) break;
        __builtin_amdgcn_s_sleep(1);
        if ((++sp & 255u) == 0u) { if (xb_ld(&bar[XB_TMO])) break; if (sp > XB_SPIN_CAP) { atomicAdd(&bar[XB_TMO], 1u); break; } }
    }
    nloc = mine > 0u ? mine : 1u; nx = cnt > 0u ? cnt : 1u;
}
__device__ __forceinline__ void xcd_barrier(const XcdBarrier& b) {
    asm volatile("s_waitcnt vmcnt(0)" ::: "memory");
    __syncthreads();
    if (threadIdx.x == 0) {
        unsigned* bar = b.bar;
        __builtin_amdgcn_s_waitcnt(0);
        unsigned nloc = b.st[0], nx = b.st[1];
        if (nloc == 0u) { xcd_barrier_complete(bar, b.x, nloc, nx); b.st[0] = nloc; b.st[1] = nx; }
        const unsigned old = xb_add(&bar[XB_XSUB(b.x)], 1u);
        const unsigned gen = old / nloc;
        if (old + 1u == (gen + 1u) * nloc) {
            __builtin_amdgcn_fence(__ATOMIC_RELEASE, "agent");
            asm volatile("s_waitcnt vmcnt(0)" ::: "memory");
            const unsigned og = xb_add(&bar[XB_TOP], 1u);
            const unsigned tg = og / nx;
            if (og + 1u == (tg + 1u) * nx) xb_add(&bar[XB_TOPGEN], 1u);
            else XB_SPIN(xb_ld(&bar[XB_TOPGEN]) == tg, bar);
            __builtin_amdgcn_fence(__ATOMIC_ACQUIRE, "agent");
            xb_add(&bar[XB_XGEN(b.x)], 1u);
            asm volatile("s_waitcnt vmcnt(0)" ::: "memory");
        } else {
            XB_SPIN(xb_ld(&bar[XB_XGEN(b.x)]) == gen, bar);
            __builtin_amdgcn_fence(__ATOMIC_ACQUIRE, "agent");
            asm volatile("s_waitcnt vmcnt(0)" ::: "memory");
        }
    }
    __syncthreads();
}

__device__ __forceinline__ void p0_prologue(const Params& P, LAS unsigned char* lds) {
    const int tid = otid();
    LAS float* tileb = (LAS float*)lds;
#define P0_DECODE(t, src_, dst_, K_, ldS_, k0_, n0_, sc_) do { int r_, sp_ = 0; \
        if ((t) < 768)       { const int j_ = (t) / 384; r_ = (t) % 384; src_ = P.in[8] + (size_t)j_ * 1024 * ABSRC; ldS_ = ABSRC; K_ = 1024; dst_ = (bf16_t*)(P.ws + WS_WABIN) + (size_t)j_ * ABN * 1024; sp_ = 1; } \
        else if ((t) < 1024) { const int q_ = (t) - 768, j_ = q_ / 128; r_ = q_ % 128; src_ = P.in[15] + (size_t)j_ * 1024 * 1024; ldS_ = 1024; K_ = 1024; dst_ = (bf16_t*)(P.ws + WS_WABOUT) + (size_t)j_ * 1024 * 1024; } \
        else if ((t) < 2304) { const int q_ = (t) - 1024, j_ = q_ / 640; r_ = q_ % 640; src_ = P.in[16] + (size_t)j_ * 1024 * SSDSRC; ldS_ = SSDSRC; K_ = 1024; dst_ = (bf16_t*)(P.ws + WS_WSSDIN) + (size_t)j_ * SSDN * 1024; } \
        else if ((t) < 2816) { const int q_ = (t) - 2304, j_ = q_ / 256; r_ = q_ % 256; src_ = P.in[23] + (size_t)j_ * 2048 * 1024; ldS_ = 1024; K_ = 2048; dst_ = (bf16_t*)(P.ws + WS_WSSDOUT) + (size_t)j_ * 1024 * 2048; } \
        else if ((t) < 4864) { const int q_ = (t) - 2816, l_ = q_ / 512; r_ = q_ % 512; src_ = P.in[24] + (size_t)l_ * 1024 * 4096; ldS_ = 4096; K_ = 1024; dst_ = (bf16_t*)(P.ws + WS_W1) + (size_t)l_ * 4096 * 1024; } \
        else                 { const int q_ = (t) - 4864, l_ = q_ / 512; r_ = q_ % 512; src_ = P.in[25] + (size_t)l_ * 4096 * 1024; ldS_ = 1024; K_ = 4096; dst_ = (bf16_t*)(P.ws + WS_W2) + (size_t)l_ * 1024 * 4096; } \
        const int nkt_ = K_ >> 7; k0_ = (r_ % nkt_) * 128; n0_ = (r_ / nkt_) * 64; sc_ = n0_ + ((sp_ && n0_ >= 1536) ? 8 : 0); } while (0)
    {
        constexpr int NT0 = 6912;
        const int rr = tid >> 4, c4 = (tid & 15) * 4;
        const int G2 = gridDim.x;
        f32x4 va[4], vb[4];
#pragma unroll
        for (int q = 0; q < 4; ++q) { va[q] = (f32x4){0.f, 0.f, 0.f, 0.f}; vb[q] = (f32x4){0.f, 0.f, 0.f, 0.f}; }
        const float* src; int ldS, sc;
        bf16_t* dstA = nullptr; int KA = 0, k0A = 0, n0A = 0; bf16_t* dstB = nullptr; int KB = 0, k0B = 0, n0B = 0;
        int tA = blockIdx.x, tB = blockIdx.x + G2;
        if (tA < NT0) { P0_DECODE(tA, src, dstA, KA, ldS, k0A, n0A, sc);
#pragma unroll
            for (int q = 0; q < 4; ++q) va[q] = *(const f32x4*)(src + (size_t)(k0A + rr + 32 * q) * ldS + sc + c4); }
        if (tB < NT0) { P0_DECODE(tB, src, dstB, KB, ldS, k0B, n0B, sc);
#pragma unroll
            for (int q = 0; q < 4; ++q) vb[q] = *(const f32x4*)(src + (size_t)(k0B + rr + 32 * q) * ldS + sc + c4); }
#define P0_STEP(V, DST, KK, K0, N0, TT, BUF) do { \
            LAS float* tile_ = tileb + (BUF) * (128 * 65); \
            _Pragma("unroll") for (int q = 0; q < 4; ++q) { const int k_ = rr + 32 * q; tile_[k_ * 65 + c4 + 0] = V[q][0]; tile_[k_ * 65 + c4 + 1] = V[q][1]; tile_[k_ * 65 + c4 + 2] = V[q][2]; tile_[k_ * 65 + c4 + 3] = V[q][3]; } \
            bf16_t* cdst_ = DST; const int cK_ = KK, ck0_ = K0, cn0_ = N0; \
            TT += 2 * G2; \
            if (TT < NT0) { P0_DECODE(TT, src, DST, KK, ldS, K0, N0, sc); \
                _Pragma("unroll") for (int q = 0; q < 4; ++q) V[q] = *(const f32x4*)(src + (size_t)(K0 + rr + 32 * q) * ldS + sc + c4); } \
            __syncthreads(); \
            { const int n_ = tid >> 3, kv_ = (tid & 7) * 16; u32x4 w0_, w1_; \
              w0_.x = pk2(tile_[(kv_ + 0) * 65 + n_], tile_[(kv_ + 1) * 65 + n_]); w0_.y = pk2(tile_[(kv_ + 2) * 65 + n_], tile_[(kv_ + 3) * 65 + n_]); \
              w0_.z = pk2(tile_[(kv_ + 4) * 65 + n_], tile_[(kv_ + 5) * 65 + n_]); w0_.w = pk2(tile_[(kv_ + 6) * 65 + n_], tile_[(kv_ + 7) * 65 + n_]); \
              w1_.x = pk2(tile_[(kv_ + 8) * 65 + n_], tile_[(kv_ + 9) * 65 + n_]); w1_.y = pk2(tile_[(kv_ + 10) * 65 + n_], tile_[(kv_ + 11) * 65 + n_]); \
              w1_.z = pk2(tile_[(kv_ + 12) * 65 + n_], tile_[(kv_ + 13) * 65 + n_]); w1_.w = pk2(tile_[(kv_ + 14) * 65 + n_], tile_[(kv_ + 15) * 65 + n_]); \
              bf16_t* dp_ = cdst_ + (size_t)(cn0_ + n_) * cK_ + ck0_ + kv_; *(u32x4*)dp_ = w0_; *(u32x4*)(dp_ + 8) = w1_; } } while (0)
#pragma unroll 1
        while (tA < NT0) {
            P0_STEP(va, dstA, KA, k0A, n0A, tA, 0);
            if (tB < NT0) P0_STEP(vb, dstB, KB, k0B, n0B, tB, 1);
        }
#undef P0_STEP
    }
#undef P0_DECODE
    const int gtid = blockIdx.x * 512 + tid, gsz = gridDim.x * 512;
    for (int idx = gtid; idx < 4 * 32 * 1024; idx += gsz) {
        const int which = idx >> 15, n = (idx >> 10) & 31, k = idx & 1023; float v = 0.f;
        if (which < 2) { const int col = n < 4 ? 1536 + n : (n < 8 ? 1540 + (n - 4) : (n < 24 ? 3080 + (n - 8) : -1));
            if (col >= 0) v = P.in[8][((size_t)which * 1024 + k) * ABSRC + col];
            ((bf16_t*)(P.ws + WS_WABG))[(size_t)which * 32768 + n * 1024 + k] = f2bf(v); }
        else { const int j = which - 2; v = P.in[16][((size_t)j * 1024 + k) * SSDSRC + 5120 + n];
            ((bf16_t*)(P.ws + WS_WSSDG))[(size_t)j * 32768 + n * 1024 + k] = f2bf(v); }
    }
    { const f32x4* xp = (const f32x4*)P.in[0]; const f32x4* xs = (const f32x4*)P.in[1]; u32x2* XB = (u32x2*)(P.ws + WS_XB);
      for (int idx0 = gtid; idx0 < MT * 256; idx0 += 4 * gsz) { f32x4 v[4];
#pragma unroll
          for (int q = 0; q < 4; ++q) { const int idx = idx0 + q * gsz; if (idx < MT * 256) v[q] = idx < MP * 256 ? xp[idx] : xs[idx - MP * 256]; }
#pragma unroll
          for (int q = 0; q < 4; ++q) { const int idx = idx0 + q * gsz; if (idx < MT * 256) { u32x2 w; w.x = pk2(v[q][0], v[q][1]); w.y = pk2(v[q][2], v[q][3]); XB[idx] = w; } } } }
}

__device__ __forceinline__ void gates_phase(LAS unsigned char* lds, const bf16_t* XB, const bf16_t* Gt, float* GT) {
    const int tid = otid(), lane = tid & 63, wave = __builtin_amdgcn_readfirstlane(tid >> 6);
    const int gw = blockIdx.x * 8 + wave, nw = gridDim.x * 8;
    LAS bf16_t* stg = (LAS bf16_t*)(lds + wave * 6912);
    const int lr = lane >> 3, lc = (lane & 7) * 8;
    for (int task = gw; task < MT / 16; task += nw) {
        const int m0 = task * 16;
        f32x4 a0 = {0.f, 0.f, 0.f, 0.f}, a1 = {0.f, 0.f, 0.f, 0.f};
        const bf16_t* ap = XB + (size_t)(m0 + lr) * 1024 + lc;
        const bf16_t* bp = Gt + (size_t)lr * 1024 + lc;
        u32x4 g[6];
#pragma unroll
        for (int i = 0; i < 2; ++i) g[i] = *(const u32x4*)(ap + (size_t)(i * 8) * 1024);
#pragma unroll
        for (int i = 0; i < 4; ++i) g[2 + i] = *(const u32x4*)(bp + (size_t)(i * 8) * 1024);
#pragma unroll 1
        for (int kb = 0; kb < 16; ++kb) {
#pragma unroll
            for (int i = 0; i < 6; ++i) *(LAS u32x4*)(stg + (i * 8 + lr) * 72 + lc) = g[i];
            if (kb + 1 < 16) {
#pragma unroll
                for (int i = 0; i < 2; ++i) g[i] = *(const u32x4*)(ap + (size_t)(i * 8) * 1024 + (kb + 1) * 64);
#pragma unroll
                for (int i = 0; i < 4; ++i) g[2 + i] = *(const u32x4*)(bp + (size_t)(i * 8) * 1024 + (kb + 1) * 64);
            }
#pragma unroll
            for (int q = 0; q < 2; ++q) { const bf16x8 a = ldsfrag(stg, 0, 72, q * 32, lane), b0 = ldsfrag(stg, 16, 72, q * 32, lane), b1 = ldsfrag(stg, 32, 72, q * 32, lane);
                a0 = mma(a, b0, a0); a1 = mma(a, b1, a1); }
        }
#pragma unroll
        for (int r = 0; r < 4; ++r) { const int row = m0 + (lane >> 4) * 4 + r; GT[(size_t)(lane & 15) * MT + row] = a0[r]; GT[(size_t)(16 + (lane & 15)) * MT + row] = a1[r]; }
    }
    __syncthreads();
}

__device__ __forceinline__ void ln_phase(const bf16_t* Y, const float* g, const float* bta, float* OUT, bf16_t* XB) {
    const int tid = otid(), lane = tid & 63, wave = tid >> 6;
    const int gw = blockIdx.x * 8 + wave, nw = gridDim.x * 8;
    const int sub = lane >> 4, l16 = lane & 15;
    for (int row0 = gw * 4; row0 < MT; row0 += nw * 4) {
        const int row = row0 + sub;
        const bf16_t* yr = Y + (size_t)row * 1024;
        u32x4 yv[8]; float s = 0.f;
#pragma unroll
        for (int k = 0; k < 8; ++k) yv[k] = *(const u32x4*)(yr + (l16 + 16 * k) * 8);
#pragma unroll
        for (int k = 0; k < 8; ++k)
#pragma unroll
            for (int e = 0; e < 8; ++e) s += bfe(yv[k], e);
        s += __shfl_xor(s, 1); s += __shfl_xor(s, 2); s += __shfl_xor(s, 4); s += __shfl_xor(s, 8);
        const float mean = s * (1.f / 1024.f); float q = 0.f;
#pragma unroll
        for (int k = 0; k < 8; ++k)
#pragma unroll
            for (int e = 0; e < 8; ++e) { const float d = bfe(yv[k], e) - mean; q += d * d; }
        q += __shfl_xor(q, 1); q += __shfl_xor(q, 2); q += __shfl_xor(q, 4); q += __shfl_xor(q, 8);
        const float rstd = rsqrtf(q * (1.f / 1024.f) + LN_EPS);
#pragma unroll
        for (int k = 0; k < 8; ++k) { const int col = (l16 + 16 * k) * 8;
            const f32x4 g0 = *(const f32x4*)(g + col), g1 = *(const f32x4*)(g + col + 4), b0 = *(const f32x4*)(bta + col), b1 = *(const f32x4*)(bta + col + 4);
            f32x4 o0, o1;
#pragma unroll
            for (int e = 0; e < 4; ++e) { o0[e] = (bfe(yv[k], e) - mean) * rstd * g0[e] + b0[e]; o1[e] = (bfe(yv[k], 4 + e) - mean) * rstd * g1[e] + b1[e]; }
            if (OUT) { *(f32x4*)(OUT + (size_t)row * 1024 + col) = o0; *(f32x4*)(OUT + (size_t)row * 1024 + col + 4) = o1; }
            u32x4 w; w.x = pk2(o0[0], o0[1]); w.y = pk2(o0[2], o0[3]); w.z = pk2(o1[0], o1[1]); w.w = pk2(o1[2], o1[3]);
            *(u32x4*)(XB + (size_t)row * 1024 + col) = w; }
    }
}

struct AbItem { int samp, b, h, c, m0, nvalid; };
__device__ __forceinline__ AbItem ab_decode(int i) {
    AbItem t; t.samp = i >= 1024;
    if (!t.samp) { t.b = i >> 7; t.h = (i >> 5) & 3; t.c = i & 31; t.m0 = t.b * 2048 + t.c * 64; t.nvalid = 64; }
    else { const int r = i - 1024; t.b = r >> 2; t.h = r & 3; t.c = 0; t.m0 = MP + t.b * 4; t.nvalid = 4; }
    return t;
}
__device__ __forceinline__ void write_vt(LAS bf16_t* VT, const u32x4& a, const u32x4& b, int tid) {
    const int s = (tid >> 3) ^ ((tid & 7) << 3), v8 = (tid & 7) * 8;
#pragma unroll
    for (int e = 0; e < 8; ++e) { VT[(v8 + e) * 72 + s] = bfr(a, e); VT[(64 + v8 + e) * 72 + s] = bfr(b, e); }
}

template <int TYPE> __device__ __forceinline__ void ab_delta_item(const Params& P, LAS unsigned char* lds, int j, int i) {
    const int tid = otid(), lane = tid & 63, wave = __builtin_amdgcn_readfirstlane(tid >> 6);
    const AbItem it = ab_decode(i);
    const int b = it.b, h = it.h, c = it.c, m0 = it.m0, nvalid = it.nvalid;
    LAS bf16_t* KT = (LAS bf16_t*)lds; LAS bf16_t* VT = (LAS bf16_t*)(lds + 9216);
    const bf16_t* Pb = (const bf16_t*)(P.ws + WS_P);
    const float* GT = (const float*)(P.ws + WS_GT);
    const int kcol = TYPE == 0 ? 256 + h * 64 : 1792 + h * 64, vcol = TYPE == 0 ? 512 + h * 128 : 2048 + h * 128;
    const int ls = tid >> 3, ld8 = (tid & 7) * 8, lv16 = (tid & 7) * 16;
    u32x4 kv = {0u, 0u, 0u, 0u}, va = {0u, 0u, 0u, 0u}, vb = {0u, 0u, 0u, 0u};
    if (ls < nvalid) { const bf16_t* rowp = Pb + (size_t)(m0 + ls) * ABN; kv = *(const u32x4*)(rowp + kcol + ld8); va = *(const u32x4*)(rowp + vcol + ld8); vb = *(const u32x4*)(rowp + vcol + 64 + ld8); }
    if (TYPE == 0) {
        LAS float* bt = (LAS float*)(lds + 27648); LAS float* igt = bt + 64; LAS float* scb = bt + 128; LAS float* sca = bt + 160;
        const float igb = P.in[9][j * 4 + h], fgb = P.in[10][j * 4 + h];
        float mprev = it.samp ? P.in[4][(j * 128 + b) * 4 + h] : 0.f;
        const bool valid = lane < nvalid;
        float pf[4], pi[4];
#pragma unroll
        for (int q = 0; q < 4; ++q) { const int cc = wave + 8 * q; pf[q] = 0.f; pi[q] = 0.f;
            if (cc <= c && valid) { const int row = (it.samp ? m0 : b * 2048 + cc * 64) + lane; pf[q] = GT[(size_t)(4 + h) * MT + row]; pi[q] = GT[(size_t)h * MT + row]; } }
#pragma unroll
        for (int q = 0; q < 4; ++q) { const int cc = wave + 8 * q;
            if (cc <= c) {
                const float lf = valid ? logsig(pf[q] + fgb) : 0.f, ig = valid ? pi[q] + igb : -INFINITY;
                const float bs = wave_scan_add(lf, lane); const float am = wave_max(ig - bs);
                if (cc == c) { bt[lane] = bs; igt[lane] = ig; }
                if (lane == 63) scb[cc] = bs;
                if (lane == 0) sca[cc] = am;
            } }
        __syncthreads();
        for (int cc = 0; cc < c; ++cc) mprev = scb[cc] + fmaxf(mprev, sca[cc]);
        const float bL = scb[c], aL = sca[c]; const float mL = bL + fmaxf(mprev, aL); const float wL0 = __expf(bL + mprev - mL);
        { float wl = 0.f; if (ls < nvalid) wl = 0.125f * __expf(bL - bt[ls] + igt[ls] - mL);
#pragma unroll
          for (int e = 0; e < 8; ++e) KT[(ld8 + e) * 72 + (ls ^ ld8)] = f2bf(bfe(kv, e) * wl); }
        if (tid == 0) { float* sc = (float*)(P.ws + WS_SCAL) + (size_t)i * 4; sc[0] = mprev; sc[1] = wL0; sc[2] = mL;
            if (it.samp) P.out[O_SM + (j * 128 + b) * 4 + h] = mL; else if (c == 31) P.out[O_PM + (j * 8 + b) * 4 + h] = mL; }
    } else {
        LAS float* gaL = (LAS float*)(lds + 28672); LAS float* Ac = (LAS float*)(lds + 32768); LAS float* seg = (LAS float*)(lds + 49408);
        const int dk = tid & 63, sg = tid >> 6;
        float g2v[2];
#pragma unroll
        for (int q = 0; q < 2; ++q) { const int idx = tid + q * 512, r = idx >> 6, s = idx & 63; g2v[q] = (s < nvalid) ? GT[(size_t)(8 + r) * MT + m0 + s] : 0.f; }
        float wcv[16];
#pragma unroll
        for (int r = 0; r < 16; ++r) wcv[r] = P.in[12][(size_t)(j * 16 + r) * 256 + h * 64 + dk];
        const float bias = P.in[13][j * 256 + h * 64 + dk];
        gaL[tid] = g2v[0]; gaL[tid + 512] = g2v[1];
        __syncthreads();
        float loc[8]; float run = 0.f;
#pragma unroll
        for (int ss = 0; ss < 8; ++ss) { const int s = sg * 8 + ss; float la = 0.f;
            if (s < nvalid) { float z = bias;
#pragma unroll
                for (int r = 0; r < 16; ++r) z += gaL[r * 64 + s] * wcv[r];
                la = logsig(z) * (1.f / 16.f); }
            run += la; loc[ss] = run; }
        seg[sg * 64 + dk] = run;
        __syncthreads();
        float off = 0.f;
#pragma unroll
        for (int g2 = 0; g2 < 8; ++g2) off += (g2 < sg) ? seg[g2 * 64 + dk] : 0.f;
        float* acg = (float*)(P.ws + WS_ACUM) + (size_t)i * 4096;
#pragma unroll
        for (int ss = 0; ss < 8; ++ss) { const int s = sg * 8 + ss; const float a = loc[ss] + off; Ac[s * 65 + dk] = a; acg[s * 64 + dk] = a; }
        __syncthreads();
#pragma unroll
        for (int e = 0; e < 8; ++e) { const int d = ld8 + e; const float wgt = __expf(Ac[63 * 65 + d] - Ac[ls * 65 + d]); KT[d * 72 + (ls ^ ld8)] = f2bf(bfe(kv, e) * wgt); }
        if (tid < 64) ((float*)(P.ws + WS_DEC))[(size_t)i * 64 + tid] = __expf(Ac[63 * 65 + tid]);
    }
    write_vt(VT, va, vb, tid);
    __syncthreads();
    f32x4 acc[4];
#pragma unroll
    for (int jj = 0; jj < 4; ++jj) acc[jj] = (f32x4){0.f, 0.f, 0.f, 0.f};
#pragma unroll
    for (int ks = 0; ks < 2; ++ks) { const bf16x8 a = ldsfrag_swz(VT, wave * 16, 72, ks * 32, lane);
#pragma unroll
        for (int jj = 0; jj < 4; ++jj) { const bf16x8 bb = ldsfrag_swz(KT, jj * 16, 72, ks * 32, lane); acc[jj] = mma(a, bb, acc[jj]); } }
    float* dct = (float*)(P.ws + WS_DCT) + (size_t)(TYPE * NITEM + i) * 8192;
#pragma unroll
    for (int jj = 0; jj < 4; ++jj)
#pragma unroll
        for (int r = 0; r < 4; ++r) dct[(wave * 16 + (lane >> 4) * 4 + r) * 64 + jj * 16 + (lane & 15)] = acc[jj][r];
    if (TYPE == 0 && tid < 64) { float sa = 0.f;
#pragma unroll 8
        for (int s = 0; s < 64; s += 8) { const u32x4 kk = *(const LAS u32x4*)(KT + tid * 72 + s);
#pragma unroll
            for (int e = 0; e < 8; ++e) sa += bfe(kk, e); }
        ((float*)(P.ws + WS_DN))[(size_t)i * 64 + tid] = sa; }
    __syncthreads();
}

__device__ __forceinline__ void ab_scan_phase(const Params& P, LAS unsigned char* lds, int j) {
    const int tid = otid();
    const float* DCT = (const float*)(P.ws + WS_DCT); bf16_t* CINT = (bf16_t*)(P.ws + WS_CINT);
    const float* SCAL = (const float*)(P.ws + WS_SCAL); const float* DEC = (const float*)(P.ws + WS_DEC);
    const float* DN = (const float*)(P.ws + WS_DN); float* NIN = (float*)(P.ws + WS_NIN);
    for (int task = blockIdx.x; task < 256 + 1024; task += gridDim.x) {
        if (task < 256) {
            const int type = task >> 7, seq = (task >> 2) & 31, q = task & 3, b = seq >> 2, h = seq & 3;
            const int e = q * 2048 + tid * 4;
            f32x4 st = {0.f, 0.f, 0.f, 0.f};
#pragma unroll 8
            for (int c = 0; c < 32; ++c) { const int i = seq * 32 + c; const size_t base = (size_t)(type * NITEM + i) * 8192 + e;
                const f32x4 d = *(const f32x4*)(DCT + base);
                f32x4 dec; if (type == 0) { const float w = SCAL[i * 4 + 1]; dec = (f32x4){w, w, w, w}; } else dec = *(const f32x4*)(DEC + (size_t)i * 64 + (e & 63));
                u32x2 w2; w2.x = pk2(st[0], st[1]); w2.y = pk2(st[2], st[3]); *(u32x2*)(CINT + base) = w2;
                st = dec * st + d; }
            float* out = P.out + (type == 0 ? O_PC : O_PS) + (size_t)((j * 8 + b) * 4 + h) * 8192;
            const int dv = e >> 6, dk = e & 63;
#pragma unroll
            for (int jj = 0; jj < 4; ++jj) out[(dk + jj) * 128 + dv] = st[jj];
            if (type == 0 && q == 0 && tid < 64) { float ns = 0.f;
#pragma unroll 1
                for (int c0 = 0; c0 < 32; c0 += 8) { float wv[8], dv8[8];
#pragma unroll
                    for (int u = 0; u < 8; ++u) { const int i = seq * 32 + c0 + u; wv[u] = SCAL[i * 4 + 1]; dv8[u] = DN[(size_t)i * 64 + tid]; }
#pragma unroll
                    for (int u = 0; u < 8; ++u) { const int i = seq * 32 + c0 + u; NIN[(size_t)i * 64 + tid] = ns; ns = wv[u] * ns + dv8[u]; } }
                P.out[O_PN + (size_t)((j * 8 + b) * 4 + h) * 64 + tid] = ns; }
        } else {
            const int r = task - 256, type = r >> 9, bh = r & 511, b = bh >> 2, h = bh & 3, i = 1024 + bh;
            LAS float* T1 = (LAS float*)lds; LAS float* T2 = (LAS float*)(lds + 33280);
            const size_t base = (size_t)(type * NITEM + i) * 8192;
#pragma unroll
            for (int k = 0; k < 4; ++k) { const int e = tid * 4 + k * 2048; const f32x4 d = *(const f32x4*)(DCT + base + e); const int dv = e >> 6, dk = e & 63;
                T1[dv * 65 + dk] = d[0]; T1[dv * 65 + dk + 1] = d[1]; T1[dv * 65 + dk + 2] = d[2]; T1[dv * 65 + dk + 3] = d[3]; }
            const float* sin = (type == 0 ? P.in[2] : P.in[5]) + (size_t)((j * 128 + b) * 4 + h) * 8192;
            float* sout = P.out + (type == 0 ? O_SC : O_SS) + (size_t)((j * 128 + b) * 4 + h) * 8192;
            const float wl0 = SCAL[i * 4 + 1];
            f32x4 s0v[4]; float decv[4];
#pragma unroll
            for (int k = 0; k < 4; ++k) { const int e2 = tid * 4 + k * 2048; s0v[k] = *(const f32x4*)(sin + e2); decv[k] = type == 0 ? wl0 : DEC[(size_t)i * 64 + (e2 >> 7)]; }
            __syncthreads();
#pragma unroll
            for (int k = 0; k < 4; ++k) { const int e2 = tid * 4 + k * 2048; const int dk = e2 >> 7, dv = e2 & 127; const f32x4 s0 = s0v[k];
                const float dec = decv[k]; f32x4 nv;
#pragma unroll
                for (int jj = 0; jj < 4; ++jj) { nv[jj] = dec * s0[jj] + T1[(dv + jj) * 65 + dk]; T2[dk * 129 + dv + jj] = s0[jj]; }
                *(f32x4*)(sout + e2) = nv; }
            __syncthreads();
#pragma unroll
            for (int k = 0; k < 4; ++k) { const int e = tid * 4 + k * 2048; const int dv = e >> 6, dk = e & 63; u32x2 w2;
                w2.x = pk2(T2[dk * 129 + dv], T2[(dk + 1) * 129 + dv]); w2.y = pk2(T2[(dk + 2) * 129 + dv], T2[(dk + 3) * 129 + dv]); *(u32x2*)(CINT + base + e) = w2; }
            if (type == 0 && tid < 64) { const float n0 = P.in[3][(size_t)((j * 128 + b) * 4 + h) * 64 + tid]; NIN[(size_t)i * 64 + tid] = n0;
                P.out[O_SN + (size_t)((j * 128 + b) * 4 + h) * 64 + tid] = wl0 * n0 + DN[(size_t)i * 64 + tid]; }
            __syncthreads();
        }
    }
}

template <int TYPE> __device__ __forceinline__ void ab_out_item(const Params& P, LAS unsigned char* lds, int j, int i) {
    const int tid = otid(), lane = tid & 63, wave = __builtin_amdgcn_readfirstlane(tid >> 6);
    const AbItem it = ab_decode(i);
    const int h = it.h, m0 = it.m0, nvalid = it.nvalid;
    LAS bf16_t* Q = (LAS bf16_t*)lds; LAS bf16_t* Kx = (LAS bf16_t*)(lds + 9216); LAS bf16_t* VT = (LAS bf16_t*)(lds + 18432); LAS bf16_t* C0T = (LAS bf16_t*)(lds + 36864);
    LAS bf16_t* Sw = (LAS bf16_t*)(lds + 55296); LAS float* Ob = (LAS float*)(lds + 64512);
    LAS float* bt = (LAS float*)(lds + 98304); LAS float* igt = bt + 64; LAS float* mt = bt + 128; LAS float* wint = bt + 192; LAS float* rden = bt + 256; LAS float* n0L = bt + 320;
    LAS float* Ac = (LAS float*)(lds + 99840);
    const bf16_t* Pb = (const bf16_t*)(P.ws + WS_P);
    const float* GT = (const float*)(P.ws + WS_GT);
    const int qcol = TYPE == 0 ? h * 64 : 1536 + h * 64, kcol = TYPE == 0 ? 256 + h * 64 : 1792 + h * 64, vcol = TYPE == 0 ? 512 + h * 128 : 2048 + h * 128, gcol = TYPE == 0 ? 1024 + h * 128 : 2560 + h * 128;
    const int ls = tid >> 3, ld8 = (tid & 7) * 8, lv16 = (tid & 7) * 16;
    u32x4 qv = {0u, 0u, 0u, 0u}, kv = {0u, 0u, 0u, 0u}, va = {0u, 0u, 0u, 0u}, vb = {0u, 0u, 0u, 0u};
    if (ls < nvalid) { const bf16_t* rowp = Pb + (size_t)(m0 + ls) * ABN; qv = *(const u32x4*)(rowp + qcol + ld8); kv = *(const u32x4*)(rowp + kcol + ld8);
        va = *(const u32x4*)(rowp + vcol + ld8); vb = *(const u32x4*)(rowp + vcol + 64 + ld8); }
    const int crow = tid >> 3, csg = (tid & 7) * 8;
    const bf16_t* csrc = (const bf16_t*)(P.ws + WS_CINT) + (size_t)(TYPE * NITEM + i) * 8192 + crow * 64 + csg;
    const u32x4 c0a = *(const u32x4*)csrc, c0b = *(const u32x4*)(csrc + 64 * 64);
    const int nt_ = tid >> 3, nsg = tid & 7;
    u32x4 gpa = {0u, 0u, 0u, 0u}, gpb = {0u, 0u, 0u, 0u};
    if (nt_ < nvalid) { const bf16_t* gp = Pb + (size_t)(m0 + nt_) * ABN + gcol + nsg * 8; gpa = *(const u32x4*)gp; gpb = *(const u32x4*)(gp + 64); }
    const float* nrm = (TYPE == 0 ? P.in[11] : P.in[14]) + j * 512 + h * 128;
    float acv[8];
    if (TYPE == 0) {
        if (wave == 0) {
            const float igb = P.in[9][j * 4 + h], fgb = P.in[10][j * 4 + h];
            float lf = 0.f, ig = -INFINITY;
            if (lane < nvalid) { lf = logsig(GT[(size_t)(4 + h) * MT + m0 + lane] + fgb); ig = GT[(size_t)h * MT + m0 + lane] + igb; }
            const float mprev = ((const float*)(P.ws + WS_SCAL))[(size_t)i * 4];
            const float n0v = ((const float*)(P.ws + WS_NIN))[(size_t)i * 64 + lane];
            const float bs = wave_scan_add(lf, lane); const float am = wave_scan_max(ig - bs, lane);
            const float mtv = bs + fmaxf(mprev, am);
            bt[lane] = bs; igt[lane] = ig; mt[lane] = mtv; wint[lane] = __expf(bs + mprev - mtv); n0L[lane] = n0v;
        }
    } else {
        const float* acg = (const float*)(P.ws + WS_ACUM) + (size_t)i * 4096;
#pragma unroll
        for (int q = 0; q < 8; ++q) acv[q] = acg[tid + q * 512];
#pragma unroll
        for (int q = 0; q < 8; ++q) { const int idx = tid + q * 512; Ac[(idx >> 6) * 65 + (idx & 63)] = acv[q]; }
        __syncthreads();
    }
    { float qf[8], kf[8];
#pragma unroll
      for (int e = 0; e < 8; ++e) {
          if (TYPE == 0) { qf[e] = bfe(qv, e); kf[e] = bfe(kv, e) * 0.125f; }
          else { const float a = Ac[ls * 65 + ld8 + e]; qf[e] = bfe(qv, e) * 0.125f * __expf(a); kf[e] = bfe(kv, e) * __expf(-a); } }
      u32x4 qw, kw; qw.x = pk2(qf[0], qf[1]); qw.y = pk2(qf[2], qf[3]); qw.z = pk2(qf[4], qf[5]); qw.w = pk2(qf[6], qf[7]);
      kw.x = pk2(kf[0], kf[1]); kw.y = pk2(kf[2], kf[3]); kw.z = pk2(kf[4], kf[5]); kw.w = pk2(kf[6], kf[7]);
      *(LAS u32x4*)(Q + ls * 72 + ld8) = qw; *(LAS u32x4*)(Kx + ls * 72 + ld8) = kw; }
    write_vt(VT, va, vb, tid);
    *(LAS u32x4*)(C0T + crow * 72 + csg) = c0a; *(LAS u32x4*)(C0T + (64 + crow) * 72 + csg) = c0b;
    __syncthreads();
    { const int tt = wave >> 1, st0 = (wave & 1) * 2;
      f32x4 sa[2] = {(f32x4){0.f, 0.f, 0.f, 0.f}, (f32x4){0.f, 0.f, 0.f, 0.f}};
#pragma unroll
      for (int ks = 0; ks < 2; ++ks) { const bf16x8 bb = ldsfrag(Q, tt * 16, 72, ks * 32, lane);
#pragma unroll
          for (int jj = 0; jj < 2; ++jj) { const bf16x8 a = ldsfrag(Kx, (st0 + jj) * 16, 72, ks * 32, lane); sa[jj] = mma(a, bb, sa[jj]); } }
      const int t = tt * 16 + (lane & 15);
      float btt = 0.f, mtt = 0.f; if (TYPE == 0) { btt = bt[t]; mtt = mt[t]; }
#pragma unroll
      for (int jj = 0; jj < 2; ++jj) { const int s0 = (st0 + jj) * 16 + (lane >> 4) * 4; float v[4];
          f32x4 b4 = {0.f, 0.f, 0.f, 0.f}, i4 = b4; if (TYPE == 0) { b4 = *(const LAS f32x4*)(bt + s0); i4 = *(const LAS f32x4*)(igt + s0); }
#pragma unroll
          for (int r = 0; r < 4; ++r) { float x = 0.f; if (s0 + r <= t) { x = sa[jj][r]; if (TYPE == 0) x *= __expf(btt - b4[r] + i4[r] - mtt); } v[r] = x; }
          u32x2 w; w.x = pk2(v[0], v[1]); w.y = pk2(v[2], v[3]); *(LAS u32x2*)(Sw + t * 72 + s0) = w; } }
    __syncthreads();
    if (TYPE == 0 && tid < 64) {
        const int t = tid; float den = 0.f, qn = 0.f;
#pragma unroll
        for (int s = 0; s < 64; s += 8) { const u32x4 sv = *(const LAS u32x4*)(Sw + t * 72 + s), qq = *(const LAS u32x4*)(Q + t * 72 + s);
#pragma unroll
            for (int e = 0; e < 8; ++e) { den += bfe(sv, e); qn += bfe(qq, e) * n0L[s + e]; } }
        den += wint[t] * qn;
        rden[t] = 1.f / fmaxf(fabsf(den), __expf(-mt[t]));
    }
    { const int tt = wave >> 1, dt0 = (wave & 1) * 4;
      f32x4 o[4];
#pragma unroll
      for (int jj = 0; jj < 4; ++jj) o[jj] = (f32x4){0.f, 0.f, 0.f, 0.f};
#pragma unroll
      for (int ks = 0; ks < 2; ++ks) { const bf16x8 bb = ldsfrag(Q, tt * 16, 72, ks * 32, lane);
#pragma unroll
          for (int jj = 0; jj < 4; ++jj) { const bf16x8 a = ldsfrag(C0T, (dt0 + jj) * 16, 72, ks * 32, lane); o[jj] = mma(a, bb, o[jj]); } }
      const int t = tt * 16 + (lane & 15);
      if (TYPE == 0) { const float w = wint[t];
#pragma unroll
          for (int jj = 0; jj < 4; ++jj) o[jj] = o[jj] * w; }
#pragma unroll
      for (int ks = 0; ks < 2; ++ks) { const bf16x8 bb = ldsfrag(Sw, tt * 16, 72, ks * 32, lane);
#pragma unroll
          for (int jj = 0; jj < 4; ++jj) { const bf16x8 a = ldsfrag_swz(VT, (dt0 + jj) * 16, 72, ks * 32, lane); o[jj] = mma(a, bb, o[jj]); } }
#pragma unroll
      for (int jj = 0; jj < 4; ++jj) *(LAS f32x4*)(Ob + t * 132 + (dt0 + jj) * 16 + (lane >> 4) * 4) = o[jj]; }
    __syncthreads();
    { bf16_t* MIXb = (bf16_t*)(P.ws + WS_MIX);
      const float rd = TYPE == 0 ? rden[nt_] : 1.f;
      float x[16]; float sm = 0.f;
#pragma unroll
      for (int q = 0; q < 4; ++q) { const f32x4 o4 = *(const LAS f32x4*)(Ob + nt_ * 132 + (q >> 1) * 64 + nsg * 8 + (q & 1) * 4);
#pragma unroll
          for (int e = 0; e < 4; ++e) { x[q * 4 + e] = o4[e] * rd; sm += x[q * 4 + e]; } }
      sm += __shfl_xor(sm, 1); sm += __shfl_xor(sm, 2); sm += __shfl_xor(sm, 4);
      const float mean = sm * (1.f / 128.f); float qv2 = 0.f;
#pragma unroll
      for (int e = 0; e < 16; ++e) { x[e] -= mean; qv2 += x[e] * x[e]; }
      qv2 += __shfl_xor(qv2, 1); qv2 += __shfl_xor(qv2, 2); qv2 += __shfl_xor(qv2, 4);
      const float rs = rsqrtf(qv2 * (1.f / 128.f) + LN_EPS);
      float o[16];
#pragma unroll
      for (int q = 0; q < 4; ++q) { const f32x4 gq = *(const f32x4*)(nrm + (q >> 1) * 64 + nsg * 8 + (q & 1) * 4);
#pragma unroll
          for (int e = 0; e < 4; ++e) { const int idx = q * 4 + e; const float p = idx < 8 ? bfe(gpa, idx & 7) : bfe(gpb, idx & 7);
              const float gate = TYPE == 0 ? sigm(p) : p * sigm(p); o[idx] = x[idx] * rs * gq[e] * gate; } }
      if (nt_ < nvalid) { u32x4 w0, w1;
          w0.x = pk2(o[0], o[1]); w0.y = pk2(o[2], o[3]); w0.z = pk2(o[4], o[5]); w0.w = pk2(o[6], o[7]);
          w1.x = pk2(o[8], o[9]); w1.y = pk2(o[10], o[11]); w1.z = pk2(o[12], o[13]); w1.w = pk2(o[14], o[15]);
          bf16_t* mp = MIXb + (size_t)(m0 + nt_) * 1024 + TYPE * 512 + h * 128 + nsg * 8;
          *(u32x4*)mp = w0; *(u32x4*)(mp + 64) = w1; } }
    __syncthreads();
}

__device__ __forceinline__ void ssd_conv_phase(const Params& P, int j) {
    const int gtid = blockIdx.x * 512 + otid(), gsz = gridDim.x * 512;
    const bf16_t* Pb = (const bf16_t*)(P.ws + WS_P); bf16_t* CONVB = (bf16_t*)(P.ws + WS_CONVB);
    const float* cw = P.in[17] + (size_t)j * 4 * 3072; const float* cb = P.in[18] + (size_t)j * 3072;
    for (int idx = gtid; idx < 1024 * 384; idx += gsz) {
        const int blk = idx / 384, c8 = idx - blk * 384, ch = c8 * 8, ms = blk * 16;
        float w[4][8], bias[8];
#pragma unroll
        for (int q = 0; q < 4; ++q) { const f32x4 a = *(const f32x4*)(cw + (size_t)q * 3072 + ch), b = *(const f32x4*)(cw + (size_t)q * 3072 + ch + 4);
            w[q][0] = a[0]; w[q][1] = a[1]; w[q][2] = a[2]; w[q][3] = a[3]; w[q][4] = b[0]; w[q][5] = b[1]; w[q][6] = b[2]; w[q][7] = b[3]; }
        { const f32x4 a = *(const f32x4*)(cb + ch), b = *(const f32x4*)(cb + ch + 4); bias[0] = a[0]; bias[1] = a[1]; bias[2] = a[2]; bias[3] = a[3]; bias[4] = b[0]; bias[5] = b[1]; bias[6] = b[2]; bias[7] = b[3]; }
        float f0[8], f1[8], f2[8];
#pragma unroll
        for (int e = 0; e < 8; ++e) { f0[e] = 0.f; f1[e] = 0.f; f2[e] = 0.f; }
        const bf16_t* src = Pb + (size_t)ms * SSDN + 2048 + ch;
        if ((ms & 2047) != 0) { const u32x4 q0 = *(const u32x4*)(src - 3 * SSDN), q1 = *(const u32x4*)(src - 2 * SSDN), q2 = *(const u32x4*)(src - SSDN);
#pragma unroll
            for (int e = 0; e < 8; ++e) { f0[e] = bfe(q0, e); f1[e] = bfe(q1, e); f2[e] = bfe(q2, e); } }
#pragma unroll 8
        for (int rr = 0; rr < 16; ++rr) {
            const u32x4 r3 = *(const u32x4*)(src + (size_t)rr * SSDN);
            float v[8];
#pragma unroll
            for (int e = 0; e < 8; ++e) { const float f3 = bfe(r3, e);
                const float a = fmaf(f3, w[3][e], fmaf(f2[e], w[2][e], fmaf(f1[e], w[1][e], fmaf(f0[e], w[0][e], bias[e]))));
                v[e] = a * sigm(a); f0[e] = f1[e]; f1[e] = f2[e]; f2[e] = f3; }
            u32x4 o; o.x = pk2(v[0], v[1]); o.y = pk2(v[2], v[3]); o.z = pk2(v[4], v[5]); o.w = pk2(v[6], v[7]);
            *(u32x4*)(CONVB + (size_t)(ms + rr) * 3072 + ch) = o;
        }
    }
    for (int idx = gtid; idx < MS * 384; idx += gsz) {
        const int ms = idx / 384, c8 = idx - ms * 384, ch = c8 * 8, b = ms >> 2, t = ms & 3;
        float v[8];
        { const f32x4 a = *(const f32x4*)(cb + ch), bb = *(const f32x4*)(cb + ch + 4); v[0] = a[0]; v[1] = a[1]; v[2] = a[2]; v[3] = a[3]; v[4] = bb[0]; v[5] = bb[1]; v[6] = bb[2]; v[7] = bb[3]; }
#pragma unroll
        for (int q = 0; q < 4; ++q) { const int tt = t - 3 + q; float raw[8];
            if (tt >= 0) { const u32x4 rv = *(const u32x4*)(Pb + (size_t)(MP + b * 4 + tt) * SSDN + 2048 + ch);
#pragma unroll
                for (int e = 0; e < 8; ++e) raw[e] = bfe(rv, e); }
            else { const float* cp = P.in[7] + ((size_t)(j * 128 + b) * 3 + (3 + tt)) * 3072 + ch; const f32x4 a = *(const f32x4*)cp, bb = *(const f32x4*)(cp + 4);
                raw[0] = a[0]; raw[1] = a[1]; raw[2] = a[2]; raw[3] = a[3]; raw[4] = bb[0]; raw[5] = bb[1]; raw[6] = bb[2]; raw[7] = bb[3]; }
            const f32x4 w0 = *(const f32x4*)(cw + (size_t)q * 3072 + ch), w1 = *(const f32x4*)(cw + (size_t)q * 3072 + ch + 4);
            v[0] += raw[0] * w0[0]; v[1] += raw[1] * w0[1]; v[2] += raw[2] * w0[2]; v[3] += raw[3] * w0[3];
            v[4] += raw[4] * w1[0]; v[5] += raw[5] * w1[1]; v[6] += raw[6] * w1[2]; v[7] += raw[7] * w1[3]; }
#pragma unroll
        for (int e = 0; e < 8; ++e) v[e] = v[e] * sigm(v[e]);
        u32x4 o; o.x = pk2(v[0], v[1]); o.y = pk2(v[2], v[3]); o.z = pk2(v[4], v[5]); o.w = pk2(v[6], v[7]);
        *(u32x4*)(CONVB + (size_t)(MP + ms) * 3072 + ch) = o;
    }
    { const float* GT = (const float*)(P.ws + WS_GT); float* DTB = (float*)(P.ws + WS_DTB); float* CS = (float*)(P.ws + WS_CS);
      const int lane = gtid & 63, gw = gtid >> 6, nw = gsz >> 6;
      for (int task = gw; task < 32 * (MT / 64); task += nw) { const int hd = task / (MT / 64), blk = task - hd * (MT / 64); const size_t idx = (size_t)hd * MT + blk * 64 + lane;
          const float dt = softplusf(GT[idx] + P.in[19][j * 32 + hd]); const float a = dt * -__expf(P.in[20][j * 32 + hd]); float cs;
          if (blk < MP / 64) cs = wave_scan_add(a, lane);
          else { const int pos = lane & 3; const float a1 = __shfl_up(a, 1), a2 = __shfl_up(a, 2), a3 = __shfl_up(a, 3); cs = a + (pos >= 1 ? a1 : 0.f) + (pos >= 2 ? a2 : 0.f) + (pos >= 3 ? a3 : 0.f); }
          DTB[idx] = dt; CS[idx] = cs; } }
}

struct SsdStep { int samp, b, head, m0, nvalid, last; };
__device__ __forceinline__ void ssd_decode(int item, int c, SsdStep& s) {
    if (item < 256) { s.samp = 0; s.b = item >> 5; s.head = item & 31; s.m0 = s.b * 2048 + c * 64; s.nvalid = 64; s.last = (c == 31); }
    else { const int r = item - 256; s.samp = 1; s.b = r >> 5; s.head = r & 31; s.m0 = MP + s.b * 4; s.nvalid = 4; s.last = 1; }
}
__device__ __forceinline__ void ssd_dma_issue(const SsdStep& s, const bf16_t* CONVB, const bf16_t* Pb, LAS unsigned char* lds, int tid, int wave) {
    const int g = s.head >> 3;
#pragma unroll
    for (int i = 0; i < 6; ++i) {
        const int q = i * 512 + tid; const int r = q / 48, cp = q - r * 48;
        const bf16_t* src;
        if (cp < 40) { const int col = cp < 8 ? s.head * 64 + cp * 8 : (cp < 24 ? 2048 + g * 128 + (cp - 8) * 8 : 2560 + g * 128 + (cp - 24) * 8); src = CONVB + (size_t)(s.m0 + r) * 3072 + col; }
        else src = Pb + (size_t)(s.m0 + r) * SSDN + s.head * 64 + (cp - 40) * 8;
        __builtin_amdgcn_global_load_lds((const unsigned*)src, (LAS unsigned*)(lds + i * 8192 + wave * 1024), 16, 0, 0);
    }
}

__device__ __forceinline__ void ssd_phase(const Params& P, LAS unsigned char* lds, int j) {
    const int tid = otid(), lane = tid & 63, wave = __builtin_amdgcn_readfirstlane(tid >> 6);
    constexpr int TILE_B = 64 * 41 * 16, TLD = 328;
    LAS bf16_t* XT = (LAS bf16_t*)(lds + 83968); LAS bf16_t* BwT = (LAS bf16_t*)(lds + 93184); LAS bf16_t* H0 = (LAS bf16_t*)(lds + 111616);
    LAS bf16_t* G = (LAS bf16_t*)(lds + 129024); LAS float* sc = (LAS float*)(lds + 138240);
    LAS float* Yb = (LAS float*)(lds + 139264);
    const bf16_t* Pb = (const bf16_t*)(P.ws + WS_P); const bf16_t* CONVB = (const bf16_t*)(P.ws + WS_CONVB);
    const float* DT = (const float*)(P.ws + WS_DTB);
    bf16_t* YG = (bf16_t*)(P.ws + WS_YG); float* SQ = (float*)(P.ws + WS_SQ);
    const int NIT = 256 + 4096;
    int item = blockIdx.x, c = 0;
    if (gridDim.x == 256) { const int x = item & 7, slot = item >> 3, pair = x * 4 + (slot >> 3); item = (pair >> 2) * 32 + (pair & 3) * 8 + (slot & 7); }
    if (item >= NIT) return;
    int eoff[6], hmul[6], gmul[6];
#pragma unroll
    for (int i = 0; i < 6; ++i) { int q = i * 512 + tid; if (q >= 64 * 41) q = 0; const int r = q / 41, cp = q - r * 41;
        if (cp < 8)       { eoff[i] = r * 3072 + cp * 8;                 hmul[i] = 64; gmul[i] = 0; }
        else if (cp < 24) { eoff[i] = r * 3072 + 2048 + (cp - 8) * 8;    hmul[i] = 0;  gmul[i] = 128; }
        else if (cp < 40) { eoff[i] = r * 3072 + 2560 + (cp - 24) * 8;   hmul[i] = 0;  gmul[i] = 128; }
        else              { eoff[i] = r * 3072;                          hmul[i] = 64; gmul[i] = 0; } }
#define SSD_DMA(st, buf) do { const int g_ = (st).head >> 3; LAS unsigned char* tb_ = lds + (buf) * TILE_B; _Pragma("unroll") for (int i = 0; i < 6; ++i) { if (i < 5 || wave == 0) { \
        const bf16_t* src_ = CONVB + (size_t)(st).m0 * 3072 + eoff[i] + (st).head * hmul[i] + g_ * gmul[i]; \
        __builtin_amdgcn_global_load_lds((const unsigned*)src_, (LAS unsigned*)(tb_ + i * 8192 + wave * 1024), 16, 0, 0); } } } while (0)
    const int zt = tid >> 3, zp8 = (tid & 7) * 8;
    SsdStep cur; ssd_decode(item, 0, cur);
    SSD_DMA(cur, 0);
    u32x4 znext = {0u, 0u, 0u, 0u};
    if (zt < cur.nvalid) znext = *(const u32x4*)(Pb + (size_t)(cur.m0 + zt) * SSDN + cur.head * 64 + zp8);
    const int pt = wave >> 1, nt0 = (wave & 1) * 4;
    const int hp = pt * 16 + (lane & 15), hn = (lane >> 4) * 4;
    f32x4 hst[4], hnx[4];
#pragma unroll
    for (int jj = 0; jj < 4; ++jj) { hst[jj] = (f32x4){0.f, 0.f, 0.f, 0.f}; hnx[jj] = (f32x4){0.f, 0.f, 0.f, 0.f}; }
    if (cur.samp) { const float* hin = P.in[6] + (size_t)((j * 128 + cur.b) * 32 + cur.head) * 8192;
#pragma unroll
        for (int jj = 0; jj < 4; ++jj) hnx[jj] = *(const f32x4*)(hin + hp * 128 + (nt0 + jj) * 16 + hn); }
    const float* CSB = (const float*)(P.ws + WS_CS);
    if (wave == 0) { float dt = 0.f; if (lane < cur.nvalid) dt = DT[(size_t)cur.head * MT + cur.m0 + lane];
        const float cs = CSB[(size_t)cur.head * MT + cur.m0 + min(lane, cur.nvalid - 1)]; sc[lane] = dt; sc[64 + lane] = cs; }
    int par = 0; float gtv = 0.f, gcs = 0.f;
    u32x4 zreg = {0u, 0u, 0u, 0u};
    u32x4 o_prev = {0u, 0u, 0u, 0u}; float sq_prev = 0.f; bf16_t* yp_prev = nullptr; float* sp_prev = nullptr; float* hp_prev = nullptr; f32x4 h_prev[4];
#pragma unroll
    for (int jj = 0; jj < 4; ++jj) h_prev[jj] = (f32x4){0.f, 0.f, 0.f, 0.f};
#define SSD_FLUSH() do { if (yp_prev) *(u32x4*)yp_prev = o_prev; if (sp_prev) *sp_prev = sq_prev; \
        if (hp_prev) { _Pragma("unroll") for (int jj = 0; jj < 4; ++jj) *(f32x4*)(hp_prev + (nt0 + jj) * 16) = h_prev[jj]; } yp_prev = nullptr; sp_prev = nullptr; hp_prev = nullptr; } while (0)
#pragma unroll 1
    for (;;) {
        const int nitem = cur.last ? item + (int)gridDim.x : item, nc = cur.last ? 0 : c + 1; const bool has_next = nitem < NIT;
        SsdStep nx = cur; if (has_next) ssd_decode(nitem, nc, nx);
        const float Dk = P.in[21][j * 32 + cur.head];
        LAS float* dts = sc + par * 128; LAS float* css = dts + 64;
        if (c == 0) {
#pragma unroll
            for (int jj = 0; jj < 4; ++jj) { hst[jj] = hnx[jj]; u32x2 w; w.x = pk2(hst[jj][0], hst[jj][1]); w.y = pk2(hst[jj][2], hst[jj][3]);
                *(LAS u32x2*)(H0 + hp * 136 + (nt0 + jj) * 16 + hn) = w; } }
        __builtin_amdgcn_s_waitcnt(0x0F70);
        RAW_BAR();
        const float csL = css[63];
        const int nvalid = cur.nvalid, m0 = cur.m0, head = cur.head;
        LAS bf16_t* tile = (LAS bf16_t*)(lds + par * TILE_B);
        const LAS bf16_t* CmP = tile + 192; const LAS bf16_t* BmP = tile + 64;
        zreg = znext;
        SSD_FLUSH();
        if (has_next) {
            if (wave == 0) { gtv = 0.f; if (lane < nx.nvalid) gtv = DT[(size_t)nx.head * MT + nx.m0 + lane]; gcs = CSB[(size_t)nx.head * MT + nx.m0 + min(lane, nx.nvalid - 1)]; }
            znext = (u32x4){0u, 0u, 0u, 0u};
            if (zt < nx.nvalid) znext = *(const u32x4*)(Pb + (size_t)(nx.m0 + zt) * SSDN + nx.head * 64 + zp8);
            if (cur.last) {
                if (nx.samp) { const float* hin = P.in[6] + (size_t)((j * 128 + nx.b) * 32 + nx.head) * 8192;
#pragma unroll
                    for (int jj = 0; jj < 4; ++jj) hnx[jj] = *(const f32x4*)(hin + hp * 128 + (nt0 + jj) * 16 + hn); }
                else {
#pragma unroll
                    for (int jj = 0; jj < 4; ++jj) hnx[jj] = (f32x4){0.f, 0.f, 0.f, 0.f}; } }
            SSD_DMA(nx, par ^ 1);
        }
        { const int rp = tid >> 4, c16 = tid & 15, r0 = 2 * rp, r1 = r0 + 1;
          u32x4 bv0 = {0u, 0u, 0u, 0u}, bv1 = bv0; float wl0 = 0.f, wl1 = 0.f;
          if (r0 < nvalid) { bv0 = *(const LAS u32x4*)(BmP + r0 * TLD + c16 * 8); wl0 = __expf(csL - css[r0]) * dts[r0]; }
          if (r1 < nvalid) { bv1 = *(const LAS u32x4*)(BmP + r1 * TLD + c16 * 8); wl1 = __expf(csL - css[r1]) * dts[r1]; }
#pragma unroll
          for (int e = 0; e < 8; ++e) *(LAS unsigned*)(BwT + (c16 * 8 + e) * 72 + (r0 ^ ((c16 & 7) << 3))) = pk2(bfe(bv0, e) * wl0, bfe(bv1, e) * wl1); }
        if (tid < 256) { const int rp = tid >> 3, c8 = tid & 7, r0 = 2 * rp, r1 = r0 + 1;
          u32x4 xv0 = {0u, 0u, 0u, 0u}, xv1 = xv0;
          if (r0 < nvalid) xv0 = *(const LAS u32x4*)(tile + r0 * TLD + c8 * 8);
          if (r1 < nvalid) xv1 = *(const LAS u32x4*)(tile + r1 * TLD + c8 * 8);
#pragma unroll
          for (int e = 0; e < 8; ++e) *(LAS unsigned*)(XT + (c8 * 8 + e) * 72 + (r0 ^ (c8 << 3))) = (unsigned)bfr(xv0, e) | ((unsigned)bfr(xv1, e) << 16); }
        { const int tt = wave >> 1, st0 = (wave & 1) * 2;
          f32x4 ca[2] = {(f32x4){0.f, 0.f, 0.f, 0.f}, (f32x4){0.f, 0.f, 0.f, 0.f}};
#pragma unroll
          for (int ks = 0; ks < 4; ++ks) { const bf16x8 bb = ldsfrag(CmP, tt * 16, TLD, ks * 32, lane);
#pragma unroll
              for (int jj = 0; jj < 2; ++jj) { const bf16x8 a = ldsfrag(BmP, (st0 + jj) * 16, TLD, ks * 32, lane); ca[jj] = mma(a, bb, ca[jj]); } }
          const int t = tt * 16 + (lane & 15); const float cst = css[t];
#pragma unroll
          for (int jj = 0; jj < 2; ++jj) { const int s0 = (st0 + jj) * 16 + (lane >> 4) * 4;
              const f32x4 cs4 = *(const LAS f32x4*)(css + s0), dt4 = *(const LAS f32x4*)(dts + s0); float v[4];
#pragma unroll
              for (int r = 0; r < 4; ++r) v[r] = (s0 + r <= t && s0 + r < nvalid) ? ca[jj][r] * __expf(cst - cs4[r]) * dt4[r] : 0.f;
              u32x2 w; w.x = pk2(v[0], v[1]); w.y = pk2(v[2], v[3]); *(LAS u32x2*)(G + t * 72 + s0) = w; } }
        RAW_BAR();
        { const int tt = wave >> 1, pp0 = (wave & 1) * 2;
          f32x4 y[2] = {(f32x4){0.f, 0.f, 0.f, 0.f}, (f32x4){0.f, 0.f, 0.f, 0.f}};
#pragma unroll
          for (int ks = 0; ks < 4; ++ks) { const bf16x8 bb = ldsfrag(CmP, tt * 16, TLD, ks * 32, lane);
#pragma unroll
              for (int jj = 0; jj < 2; ++jj) { const bf16x8 a = ldsfrag(H0, (pp0 + jj) * 16, 136, ks * 32, lane); y[jj] = mma(a, bb, y[jj]); } }
          const int t = tt * 16 + (lane & 15); const float ew = __expf(css[t]);
          y[0] = y[0] * ew; y[1] = y[1] * ew;
#pragma unroll
          for (int ks = 0; ks < 2; ++ks) { const bf16x8 bb = ldsfrag(G, tt * 16, 72, ks * 32, lane);
#pragma unroll
              for (int jj = 0; jj < 2; ++jj) { const bf16x8 a = ldsfrag_swz(XT, (pp0 + jj) * 16, 72, ks * 32, lane); y[jj] = mma(a, bb, y[jj]); } }
#pragma unroll
          for (int jj = 0; jj < 2; ++jj) { const int p0 = (pp0 + jj) * 16 + (lane >> 4) * 4;
              const u32x2 xw = *(const LAS u32x2*)(tile + t * TLD + p0);
              f32x4 o; o[0] = y[jj][0] + Dk * __uint_as_float(xw.x << 16); o[1] = y[jj][1] + Dk * __uint_as_float(xw.x & 0xffff0000u);
              o[2] = y[jj][2] + Dk * __uint_as_float(xw.y << 16); o[3] = y[jj][3] + Dk * __uint_as_float(xw.y & 0xffff0000u);
              *(LAS f32x4*)(Yb + t * 68 + p0) = o; } }
        { const float dec = __expf(csL);
#pragma unroll
          for (int jj = 0; jj < 4; ++jj) hst[jj] = hst[jj] * dec;
#pragma unroll
          for (int ks = 0; ks < 2; ++ks) { const bf16x8 bb = ldsfrag_swz(XT, pt * 16, 72, ks * 32, lane);
#pragma unroll
              for (int jj = 0; jj < 4; ++jj) { const bf16x8 a = ldsfrag_swz(BwT, (nt0 + jj) * 16, 72, ks * 32, lane); hst[jj] = mma(a, bb, hst[jj]); } } }
        RAW_BAR();
        { const int t = tid >> 3, p8 = (tid & 7) * 8;
          const f32x4 y0 = *(const LAS f32x4*)(Yb + t * 68 + p8), y1 = *(const LAS f32x4*)(Yb + t * 68 + p8 + 4);
          float yg[8]; float sq = 0.f;
#pragma unroll
          for (int e = 0; e < 8; ++e) { const float z = bfe(zreg, e); const float yv = (e < 4 ? y0[e & 3] : y1[e & 3]) * (z * sigm(z)); yg[e] = yv; sq += yv * yv; }
          sq += __shfl_xor(sq, 1); sq += __shfl_xor(sq, 2); sq += __shfl_xor(sq, 4);
          if (t < nvalid) { o_prev.x = pk2(yg[0], yg[1]); o_prev.y = pk2(yg[2], yg[3]); o_prev.z = pk2(yg[4], yg[5]); o_prev.w = pk2(yg[6], yg[7]);
              yp_prev = YG + (size_t)(m0 + t) * 2048 + head * 64 + p8;
              if ((tid & 7) == 0) { sq_prev = sq; sp_prev = SQ + (size_t)(m0 + t) * 32 + head; } } }
        if (cur.last) { float* hout = P.out + (cur.samp ? O_SH + (size_t)((j * 128 + cur.b) * 32 + head) * 8192 : O_PH + (size_t)((j * 8 + cur.b) * 32 + head) * 8192);
            hp_prev = hout + hp * 128 + hn;
#pragma unroll
            for (int jj = 0; jj < 4; ++jj) h_prev[jj] = hst[jj]; }
        else {
#pragma unroll
            for (int jj = 0; jj < 4; ++jj) { u32x2 w; w.x = pk2(hst[jj][0], hst[jj][1]); w.y = pk2(hst[jj][2], hst[jj][3]); *(LAS u32x2*)(H0 + hp * 136 + (nt0 + jj) * 16 + hn) = w; } }
        if (!has_next) break;
        if (wave == 0) { LAS float* nd = sc + (par ^ 1) * 128; nd[lane] = gtv; nd[64 + lane] = gcs; }
        cur = nx; item = nitem; c = nc; par ^= 1;
    }
    SSD_FLUSH();
#undef SSD_FLUSH
#undef SSD_DMA
    asm volatile("s_waitcnt vmcnt(0)" ::: "memory");
    __syncthreads();
}

__device__ __forceinline__ void ssd_norm_phase(const Params& P, int j) {
    const int gtid = blockIdx.x * 512 + otid(), gsz = gridDim.x * 512;
    const bf16_t* YG = (const bf16_t*)(P.ws + WS_YG); const float* SQ = (const float*)(P.ws + WS_SQ); bf16_t* MIXb = (bf16_t*)(P.ws + WS_MIX);
    const float* ng = P.in[22] + (size_t)j * 2048;
    for (int idx0 = gtid; idx0 < MT * 256; idx0 += 4 * gsz) {
        f32x4 s0[4], s1[4]; u32x4 yv[4];
#pragma unroll
        for (int q = 0; q < 4; ++q) { const int idx = idx0 + q * gsz; if (idx < MT * 256) { const int m = idx >> 8, c8 = idx & 255, g = c8 >> 6;
            s0[q] = *(const f32x4*)(SQ + (size_t)m * 32 + g * 8); s1[q] = *(const f32x4*)(SQ + (size_t)m * 32 + g * 8 + 4); yv[q] = *(const u32x4*)(YG + (size_t)m * 2048 + c8 * 8); } }
#pragma unroll
        for (int q = 0; q < 4; ++q) { const int idx = idx0 + q * gsz; if (idx < MT * 256) { const int m = idx >> 8, c8 = idx & 255;
            const float ss = ((s0[q][0] + s0[q][1]) + (s0[q][2] + s0[q][3])) + ((s1[q][0] + s1[q][1]) + (s1[q][2] + s1[q][3]));
            const float sc = rsqrtf(ss * (1.f / 512.f) + LN_EPS);
            const f32x4 g0 = *(const f32x4*)(ng + c8 * 8), g1 = *(const f32x4*)(ng + c8 * 8 + 4);
            u32x4 w; w.x = pk2(bfe(yv[q], 0) * sc * g0[0], bfe(yv[q], 1) * sc * g0[1]); w.y = pk2(bfe(yv[q], 2) * sc * g0[2], bfe(yv[q], 3) * sc * g0[3]);
            w.z = pk2(bfe(yv[q], 4) * sc * g1[0], bfe(yv[q], 5) * sc * g1[1]); w.w = pk2(bfe(yv[q], 6) * sc * g1[2], bfe(yv[q], 7) * sc * g1[3]);
            *(u32x4*)(MIXb + (size_t)m * 2048 + c8 * 8) = w; } }
    }
    const bf16_t* Pb = (const bf16_t*)(P.ws + WS_P);
    for (int idx = gtid; idx < (8 + 128) * 3 * 3072; idx += gsz) {
        const int ch = idx % 3072, rw = idx / 3072, w = rw % 3, bb = rw / 3;
        if (bb < 8) P.out[O_PCV + ((size_t)(j * 8 + bb) * 3 + w) * 3072 + ch] = bf2f(Pb[(size_t)(bb * 2048 + 2045 + w) * SSDN + 2048 + ch]);
        else { const int b = bb - 8; P.out[O_SCV + ((size_t)(j * 128 + b) * 3 + w) * 3072 + ch] = bf2f(Pb[(size_t)(MP + b * 4 + 1 + w) * SSDN + 2048 + ch]); }
    }
}

template <int EPI> __device__ __forceinline__ void small_gemm(LAS unsigned char* lds, const bf16_t* A, const bf16_t* Bt, int N, int K, bf16_t* O, const bf16_t* X, bf16_t* Y) {
    const int tid = otid(), lane = tid & 63, wave = __builtin_amdgcn_readfirstlane(tid >> 6);
    LAS float* red = (LAS float*)lds;
    LAS bf16_t* stg = (LAS bf16_t*)(lds + wave * 13824);
    const int ksl = K >> 3, nblk = ksl >> 6, nunits = 16 * (N >> 6);
    const int lr = lane >> 3, lc = (lane & 7) * 8;
    for (int u = blockIdx.x; u < nunits; u += gridDim.x) {
        const int rb = u & 15, cb = u >> 4;
        f32x4 acc[2][4];
#pragma unroll
        for (int m = 0; m < 2; ++m)
#pragma unroll
            for (int n = 0; n < 4; ++n) acc[m][n] = (f32x4){0.f, 0.f, 0.f, 0.f};
        const bf16_t* ap = A + (size_t)(rb * 32 + lr) * K + wave * ksl + lc;
        const bf16_t* bp = Bt + (size_t)(cb * 64 + lr) * K + wave * ksl + lc;
        u32x4 g[12];
#pragma unroll
        for (int i = 0; i < 4; ++i) g[i] = *(const u32x4*)(ap + (size_t)(i * 8) * K);
#pragma unroll
        for (int i = 0; i < 8; ++i) g[4 + i] = *(const u32x4*)(bp + (size_t)(i * 8) * K);
#pragma unroll 1
        for (int kb = 0; kb < nblk; ++kb) {
#pragma unroll
            for (int i = 0; i < 12; ++i) *(LAS u32x4*)(stg + (i * 8 + lr) * 72 + lc) = g[i];
            if (kb + 1 < nblk) {
#pragma unroll
                for (int i = 0; i < 4; ++i) g[i] = *(const u32x4*)(ap + (size_t)(i * 8) * K + (kb + 1) * 64);
#pragma unroll
                for (int i = 0; i < 8; ++i) g[4 + i] = *(const u32x4*)(bp + (size_t)(i * 8) * K + (kb + 1) * 64);
            }
#pragma unroll
            for (int q = 0; q < 2; ++q) { const bf16x8 a0 = ldsfrag(stg, 0, 72, q * 32, lane), a1 = ldsfrag(stg, 16, 72, q * 32, lane);
#pragma unroll
                for (int n = 0; n < 4; ++n) { const bf16x8 bq = ldsfrag(stg, 32 + n * 16, 72, q * 32, lane); acc[0][n] = mma(a0, bq, acc[0][n]); acc[1][n] = mma(a1, bq, acc[1][n]); } }
        }
        __syncthreads();
#pragma unroll
        for (int m = 0; m < 2; ++m)
#pragma unroll
            for (int n = 0; n < 4; ++n)
#pragma unroll
                for (int r = 0; r < 4; ++r) red[(wave * 32 + m * 16 + (lane >> 4) * 4 + r) * 68 + n * 16 + (lane & 15)] = acc[m][n][r];
        __syncthreads();
        { const int row = tid >> 4, c4 = (tid & 15) * 4;
          f32x4 s = *(const LAS f32x4*)(red + row * 68 + c4);
#pragma unroll
          for (int w = 1; w < 8; ++w) s = s + *(const LAS f32x4*)(red + (w * 32 + row) * 68 + c4);
          const int grow = rb * 32 + row, gcol = cb * 64 + c4;
          if (EPI == 2) { const u32x2 x = *(const u32x2*)(X + (size_t)grow * 1024 + gcol); u32x2 w2;
              w2.x = pk2(s[0] + DN_ALPHA * __uint_as_float(x.x << 16), s[1] + DN_ALPHA * __uint_as_float(x.x & 0xffff0000u));
              w2.y = pk2(s[2] + DN_ALPHA * __uint_as_float(x.y << 16), s[3] + DN_ALPHA * __uint_as_float(x.y & 0xffff0000u));
              *(u32x2*)(Y + (size_t)grow * 1024 + gcol) = w2; }
          else { if (EPI == 1) {
#pragma unroll
                  for (int q = 0; q < 4; ++q) { const float a = fmaxf(s[q], 0.f); s[q] = a * a; } }
              u32x2 w2; w2.x = pk2(s[0], s[1]); w2.y = pk2(s[2], s[3]); *(u32x2*)(O + (size_t)grow * N + gcol) = w2; } }
        __syncthreads();
    }
}

#ifndef REP_GEMM
#define REP_GEMM 1
#endif
#ifndef REP_P0
#define REP_P0 1
#endif
#ifndef REP_AB
#define REP_AB 1
#endif
#ifndef REP_S2
#define REP_S2 1
#endif
#ifndef REP_CONV
#define REP_CONV 1
#endif
#ifndef REP_BAR
#define REP_BAR 1
#endif
#ifndef REP_LN
#define REP_LN 1
#endif
#ifndef REP_SG
#define REP_SG 1
#endif
__global__ void __launch_bounds__(512) mega_fwd(Params P) {
    extern __shared__ __attribute__((aligned(16))) unsigned char smem[];
    LAS unsigned char* lds = (LAS unsigned char*)smem;
    const int tid = otid();
    volatile LAS unsigned* bst = (volatile LAS unsigned*)(lds + LDS_BAR_OFF);
    if (tid < 64) bst[tid] = 0u;
    __syncthreads();
    XcdBarrier bar = xcd_barrier_post((unsigned*)(P.ws + WS_CTL), bst);
    cg::grid_group grid = cg::this_grid();
#define GRID_BAR() do { for (int rb_ = 0; rb_ < REP_BAR; ++rb_) xcd_barrier(bar); } while (0)

#ifndef SKIP_P0
    for (int rep_ = 0; rep_ < REP_P0; ++rep_)
    p0_prologue(P, lds);
#endif
    if (P.ws == nullptr) grid.sync();
    GRID_BAR();

    const bf16_t* XB = (const bf16_t*)(P.ws + WS_XB); bf16_t* Y = (bf16_t*)(P.ws + WS_Y);
    bf16_t* Pb = (bf16_t*)(P.ws + WS_P); bf16_t* MIXb = (bf16_t*)(P.ws + WS_MIX); float* GT = (float*)(P.ws + WS_GT);
#pragma unroll 1
    for (int l = 0; l < 4; ++l) {
        const int j = l >> 1, ssd = l & 1;
        { const bf16_t* Bt = ssd ? (const bf16_t*)(P.ws + WS_WSSDIN) + (size_t)j * SSDN * 1024 : (const bf16_t*)(P.ws + WS_WABIN) + (size_t)j * ABN * 1024;
          const int N = ssd ? SSDN : ABN;
          pg8::Gemm g{XB, Bt, MP, N, 1024}; pg8::StaticOrder S; S.init(MP, N, gridDim.x, blockIdx.x);
          pg8::EpiB<0> E{Pb, N};
#ifndef SKIP_G1
          for (int rep_ = 0; rep_ < REP_GEMM; ++rep_)
          pg8::gemm_phase<pg8::EpiB<0>, pg8::StaticOrder>(lds, g, S, E, nullptr);
#endif
#ifndef SKIP_GATES
          for (int rep_ = 0; rep_ < REP_SG; ++rep_)
          small_gemm<0>(lds, XB + (size_t)MP * 1024, Bt, N, 1024, Pb + (size_t)MP * N, nullptr, nullptr);
          gates_phase(lds, XB, ssd ? (const bf16_t*)(P.ws + WS_WSSDG) + (size_t)j * 32768 : (const bf16_t*)(P.ws + WS_WABG) + (size_t)j * 32768, GT);
#endif
 }
        GRID_BAR();
        if (!ssd) {
#ifndef SKIP_A2
            for (int rep_ = 0; rep_ < REP_AB; ++rep_)
            for (int w = blockIdx.x; w < 2 * NITEM; w += gridDim.x) { if (w < NITEM) ab_delta_item<0>(P, lds, j, w); else ab_delta_item<1>(P, lds, j, w - NITEM); }
#endif
            GRID_BAR();
#ifndef SKIP_A3
            for (int rep_ = 0; rep_ < REP_AB; ++rep_)
            ab_scan_phase(P, lds, j);
#endif
            GRID_BAR();
#ifndef SKIP_A4
            for (int rep_ = 0; rep_ < REP_AB; ++rep_)
            for (int w = blockIdx.x; w < 2 * NITEM; w += gridDim.x) { if (w < NITEM) ab_out_item<0>(P, lds, j, w); else ab_out_item<1>(P, lds, j, w - NITEM); }
#endif
            GRID_BAR();
        } else {
            for (int rep_ = 0; rep_ < REP_CONV; ++rep_)
            ssd_conv_phase(P, j);
            GRID_BAR();
#ifndef SKIP_S2
            for (int rep_ = 0; rep_ < REP_S2; ++rep_)
            ssd_phase(P, lds, j);
#endif
            GRID_BAR();
#ifndef SKIP_S3
            for (int rep_ = 0; rep_ < REP_CONV; ++rep_)
            ssd_norm_phase(P, j);
#endif
            GRID_BAR();
        }
        { const bf16_t* Bt = ssd ? (const bf16_t*)(P.ws + WS_WSSDOUT) + (size_t)j * 1024 * 2048 : (const bf16_t*)(P.ws + WS_WABOUT) + (size_t)j * 1024 * 1024;
          const int K = ssd ? 2048 : 1024;
          pg8::Gemm g{MIXb, Bt, MP, 1024, K}; pg8::StaticOrder S; S.init(MP, 1024, gridDim.x, blockIdx.x);
          pg8::EpiRes E{XB, Y, 1024, DN_ALPHA};
#ifndef SKIP_G2
          for (int rep_ = 0; rep_ < REP_GEMM; ++rep_)
          pg8::gemm_phase<pg8::EpiRes, pg8::StaticOrder>(lds, g, S, E, nullptr);
#endif
          for (int rep_ = 0; rep_ < REP_SG; ++rep_)
          small_gemm<2>(lds, MIXb + (size_t)MP * K, Bt, 1024, K, nullptr, XB + (size_t)MP * 1024, Y + (size_t)MP * 1024);
 }
        GRID_BAR();
        for (int rep_ = 0; rep_ < REP_LN; ++rep_)
        ln_phase(Y, P.in[26] + (size_t)l * 1024, P.in[27] + (size_t)l * 1024, nullptr, (bf16_t*)(P.ws + WS_XB));
        GRID_BAR();
        { pg8::Gemm g{XB, (const bf16_t*)(P.ws + WS_W1) + (size_t)l * 4096 * 1024, MP, DFF, 1024}; pg8::StaticOrder S; S.init(MP, DFF, gridDim.x, blockIdx.x);
          pg8::EpiB<1> E{Pb, DFF};
#ifndef SKIP_G3
          for (int rep_ = 0; rep_ < REP_GEMM; ++rep_)
          pg8::gemm_phase<pg8::EpiB<1>, pg8::StaticOrder>(lds, g, S, E, nullptr);
#endif
          for (int rep_ = 0; rep_ < REP_SG; ++rep_)
          small_gemm<1>(lds, XB + (size_t)MP * 1024, g.Bt, DFF, 1024, Pb + (size_t)MP * DFF, nullptr, nullptr);
 }
        GRID_BAR();
        { pg8::Gemm g{Pb, (const bf16_t*)(P.ws + WS_W2) + (size_t)l * 1024 * 4096, MP, 1024, DFF}; pg8::StaticOrder S; S.init(MP, 1024, gridDim.x, blockIdx.x);
          pg8::EpiRes E{XB, Y, 1024, DN_ALPHA};
#ifndef SKIP_G4
          for (int rep_ = 0; rep_ < REP_GEMM; ++rep_)
          pg8::gemm_phase<pg8::EpiRes, pg8::StaticOrder>(lds, g, S, E, nullptr);
#endif
          for (int rep_ = 0; rep_ < REP_SG; ++rep_)
          small_gemm<2>(lds, Pb + (size_t)MP * DFF, g.Bt, 1024, DFF, nullptr, XB + (size_t)MP * 1024, Y + (size_t)MP * 1024);
 }
        GRID_BAR();
        for (int rep_ = 0; rep_ < REP_LN; ++rep_)
        ln_phase(Y, P.in[28] + (size_t)l * 1024, P.in[29] + (size_t)l * 1024, l == 3 ? P.out : nullptr, (bf16_t*)(P.ws + WS_XB));
        if (l < 3) GRID_BAR();
    }
}

extern "C" void kernel_launch(void* const* d_in, const int* in_sizes, int n_in, void* d_out, int out_size, void* d_ws, size_t ws_size, hipStream_t stream) {
    static int grid = 0;
    if (grid == 0) {
        if (n_in != 30 || (size_t)out_size != O_END || ws_size < WS_END) { fprintf(stderr, "kernel_launch: unexpected shapes (n_in %d, out %d, ws %zu)\n", n_in, out_size, ws_size); grid = -1; return; }
        int dev = 0, cus = 0, per_cu = 0;
        (void)hipGetDevice(&dev); (void)hipDeviceGetAttribute(&cus, hipDeviceAttributeMultiprocessorCount, dev);
        (void)hipFuncSetAttribute((const void*)mega_fwd, hipFuncAttributeMaxDynamicSharedMemorySize, LDS_BYTES);
        (void)hipOccupancyMaxActiveBlocksPerMultiprocessor(&per_cu, (const void*)mega_fwd, 512, LDS_BYTES);
        if (per_cu < 1) { fprintf(stderr, "kernel_launch: occupancy query says %d blocks per CU\n", per_cu); per_cu = 1; }
        grid = cus * per_cu; if (grid > 256) grid = 256;
        (void)hipGetLastError();
    }
    if (grid < 0) return;
    (void)hipMemsetAsync((char*)d_ws + WS_CTL, 0, CTL_BYTES, stream);
    Params p{};
    for (int i = 0; i < 30; ++i) p.in[i] = (const float*)d_in[i];
    p.out = (float*)d_out; p.ws = (unsigned char*)d_ws;
    void* args[] = {&p};
    hipError_t e = hipLaunchCooperativeKernel((const void*)mega_fwd, dim3(grid), dim3(512), args, LDS_BYTES, stream);
    if (e != hipSuccess) fprintf(stderr, "kernel_launch: cooperative launch failed: %s (grid %d)\n", hipGetErrorString(e), grid);
}
```

```cpp
#include <hip/hip_runtime.h>
#include <hip/hip_cooperative_groups.h>
#include <cstdio>
namespace cg = cooperative_groups;

namespace pg8 {
#define PG8_LAS __attribute__((address_space(3)))
typedef unsigned short bf16_t;
typedef short bf16x8 __attribute__((ext_vector_type(8)));
typedef float f32x4 __attribute__((ext_vector_type(4)));
typedef unsigned u32x4 __attribute__((ext_vector_type(4)));
constexpr int BM = 256, BK = 64, HALF = 128, HTB = HALF * BK * 2  , STAGE_BYTES = 8 * HTB, NXCD = 8, WGM = 8;

__host__ __device__ __forceinline__ int lds_byte(int r, int c) { const int st = (r >> 4) * 2 + (c >> 5), rr = r & 15, cc = c & 31, ob = rr * 64 + cc * 2; return st * 1024 + (ob ^ (((ob >> 9) & 1) << 5)); }
__host__ __device__ __forceinline__ void stage_rc(int b, int& R, int& C) { const int st = b / 1024, sb = b % 1024, swz = sb ^ (((sb >> 9) & 1) << 5); R = (st >> 1) * 16 + swz / 64; C = (st & 1) * 32 + (swz % 64) / 2; }
__host__ __device__ __forceinline__ int perm32(int rho) { const int n = rho >> 4, i = rho & 15; return 8 * (i >> 2) + 4 * n + (i & 3); }

struct Unit { int pm, pn; };
struct Gemm { const bf16_t* A; const bf16_t* Bt; int M, N, K; };

struct StaticOrder {
    int nM, nN, nwg, G, c;
    __host__ __device__ void init(int M, int N, int G_, int c_) { nM = M / BM; nN = N / BM; nwg = nM * nN; G = G_; c = c_; }
    __host__ __device__ bool next(int i, Unit& u) const {
        const long L = (long)i * G + c; if (L >= nwg) return false;
        int wgid = (int)L; { const int q = nwg / NXCD, r = nwg % NXCD, xcd = wgid % NXCD, off = wgid / NXCD; wgid = (xcd < r ? xcd * (q + 1) : r * (q + 1) + (xcd - r) * q) + off; }
        const int nig = WGM * nN, gid = wgid / nig, fm = gid * WGM, gsz = (nM - fm) < WGM ? (nM - fm) : WGM;
        u.pm = fm + ((wgid % nig) % gsz); u.pn = (wgid % nig) / gsz; return true;
    }
    __device__ __forceinline__ void a_ready(const Unit&) const {}
    __device__ __forceinline__ void done(const Unit&) const {}
};
__device__ __forceinline__ unsigned cvt_pk_bf16(float lo, float hi) { unsigned r; asm volatile("v_cvt_pk_bf16_f32 %0, %1, %2" : "=v"(r) : "v"(lo), "v"(hi)); return r; }

template <int ACT  > struct EpiB {
    static constexpr bool PERM = true, AFTER_DRAIN = false;
    bf16_t* O; int ldc;
    __device__ __forceinline__ void operator()(const f32x4 (&acc)[2][2][4][2], const Unit& u, int wr, int wc, int fr, int fq) const {
        const int row0 = u.pm * BM + wr * 64 + fr, col0 = u.pn * BM + wc * 32 + 8 * fq;
#pragma unroll
        for (int ai = 0; ai < 2; ++ai)
#pragma unroll
            for (int m = 0; m < 4; ++m) { bf16_t* rowp = O + (size_t)(row0 + ai * HALF + m * 16) * ldc + col0;
#pragma unroll
                for (int bj = 0; bj < 2; ++bj) { f32x4 v0 = acc[ai][bj][m][0], v1 = acc[ai][bj][m][1];
                    if (ACT == 1) {
#pragma unroll
                        for (int q = 0; q < 4; ++q) { const float a = fmaxf(v0[q], 0.f), b = fmaxf(v1[q], 0.f); v0[q] = a * a; v1[q] = b * b; } }
                    u32x4 w; w.x = cvt_pk_bf16(v0[0], v0[1]); w.y = cvt_pk_bf16(v0[2], v0[3]); w.z = cvt_pk_bf16(v1[0], v1[1]); w.w = cvt_pk_bf16(v1[2], v1[3]);
                    *(u32x4*)(rowp + bj * HALF) = w; } }
    }
};
struct EpiRes {
    static constexpr bool PERM = true, AFTER_DRAIN = false;
    const bf16_t* X; bf16_t* Y; int ldc; float alpha;
    __device__ __forceinline__ void operator()(const f32x4 (&acc)[2][2][4][2], const Unit& u, int wr, int wc, int fr, int fq) const {
        const int row0 = u.pm * BM + wr * 64 + fr, col0 = u.pn * BM + wc * 32 + 8 * fq;
#pragma unroll
        for (int ai = 0; ai < 2; ++ai)
#pragma unroll
            for (int m = 0; m < 4; ++m) { const size_t off = (size_t)(row0 + ai * HALF + m * 16) * ldc + col0;
#pragma unroll
                for (int bj = 0; bj < 2; ++bj) { const u32x4 x = *(const u32x4*)(X + off + bj * HALF); const f32x4 v0 = acc[ai][bj][m][0], v1 = acc[ai][bj][m][1];
                    u32x4 w;
                    w.x = cvt_pk_bf16(v0[0] + alpha * __uint_as_float(x.x << 16), v0[1] + alpha * __uint_as_float(x.x & 0xffff0000u));
                    w.y = cvt_pk_bf16(v0[2] + alpha * __uint_as_float(x.y << 16), v0[3] + alpha * __uint_as_float(x.y & 0xffff0000u));
                    w.z = cvt_pk_bf16(v1[0] + alpha * __uint_as_float(x.z << 16), v1[1] + alpha * __uint_as_float(x.z & 0xffff0000u));
                    w.w = cvt_pk_bf16(v1[2] + alpha * __uint_as_float(x.w << 16), v1[3] + alpha * __uint_as_float(x.w & 0xffff0000u));
                    *(u32x4*)(Y + off + bj * HALF) = w; }
                asm volatile("" ::: "memory"); }
    }
};

template <class Epi, class Sched, bool STAMP = false>
__device__ __forceinline__ void gemm_phase(PG8_LAS unsigned char* lds, const Gemm g, const Sched& S, const Epi& E, unsigned long long* stamps) {
    int tid_o = threadIdx.x; asm volatile("" : "+v"(tid_o)); const int tid = tid_o, wid = __builtin_amdgcn_readfirstlane(tid >> 6), lane = tid & 63, wr = wid >> 2, wc = wid & 3, fr = lane & 15, fq = lane >> 4;
    const int K = g.K, nt = K / BK;
    int ts_lo = 0, ts_hi = 0, nts = 0; const unsigned long long rt_entry = STAMP ? (unsigned long long)wall_clock64() : 0ull;
#define PG8_STAMP() do { if (STAMP && wid == 0 && nts < 64) { const unsigned long long _c = (unsigned long long)clock64(); \
        ts_lo = (lane == nts) ? (int)(unsigned)_c : ts_lo; ts_hi = (lane == nts) ? (int)(unsigned)(_c >> 32) : ts_hi; ++nts; } } while (0)
    PG8_STAMP();
    unsigned voffA[2], voffB[2];
#pragma unroll
    for (int i = 0; i < 2; ++i) { int R, C; stage_rc(tid * 16 + i * 8192, R, C); const int Rb = Epi::PERM ? ((R & ~31) + perm32(R & 31)) : R;
        voffA[i] = (unsigned)(R * K + C) * 2u; voffB[i] = (unsigned)(Rb * K + C) * 2u; }
    const size_t kstep = (size_t)(BK * 2);
    const size_t hstep = (size_t)HALF * K * 2;
    const size_t tstep = 2 * hstep;
    const unsigned ldsw = (unsigned)wid * 1024u;
    const int aoff = lds_byte(wr * 64 + fr, fq * 8), boff = lds_byte(wc * 32 + fr, fq * 8);
#define PG8_SA(b, h) (((b) * 2 + (h)) * HTB)
#define PG8_SB(b, h) ((4 + (b) * 2 + (h)) * HTB)
#define PG8_STAGE(bufoff, gbase, voff) do { _Pragma("unroll") for (int _i = 0; _i < 2; ++_i) \
        __builtin_amdgcn_global_load_lds((const unsigned*)((const char*)(gbase) + (voff)[_i]), (PG8_LAS unsigned*)(lds + (bufoff) + ldsw + _i * 8192), 16, 0, 0); } while (0)
#define PG8_LDA(dst, b, h) do { _Pragma("unroll") for (int m = 0; m < 4; ++m) _Pragma("unroll") for (int k = 0; k < 2; ++k) dst[m][k] = *(const PG8_LAS bf16x8*)(lds + PG8_SA(b, h) + aoff + m * 2048 + k * 1024); } while (0)
#define PG8_LDB(dst, b, h) do { _Pragma("unroll") for (int n = 0; n < 2; ++n) _Pragma("unroll") for (int k = 0; k < 2; ++k) dst[n][k] = *(const PG8_LAS bf16x8*)(lds + PG8_SB(b, h) + boff + n * 2048 + k * 1024); } while (0)
#define PG8_MMA(ai, bj, At, Bt) do { __builtin_amdgcn_s_setprio(1); _Pragma("unroll") for (int m = 0; m < 4; ++m) _Pragma("unroll") for (int n = 0; n < 2; ++n) _Pragma("unroll") for (int k = 0; k < 2; ++k) \
        acc[ai][bj][m][n] = __builtin_amdgcn_mfma_f32_16x16x32_bf16(Bt[n][k], At[m][k], acc[ai][bj][m][n], 0, 0, 0); __builtin_amdgcn_s_setprio(0); } while (0)
#define PG8_WAIT_V(n) asm volatile("s_waitcnt vmcnt(" #n ")" ::: "memory")
#define PG8_WAIT_L(n) asm volatile("s_waitcnt lgkmcnt(" #n ")" ::: "memory")
#define PG8_BAR __builtin_amdgcn_s_barrier()
#define PG8_SCHED __builtin_amdgcn_sched_barrier(0)
    Unit cur, nxt; int ui = 0;
    if (!S.next(0, cur)) return;
    f32x4 acc[2][2][4][2];
#pragma unroll
    for (int a = 0; a < 2; ++a)
#pragma unroll
        for (int b = 0; b < 2; ++b)
#pragma unroll
            for (int m = 0; m < 4; ++m)
#pragma unroll
                for (int n = 0; n < 2; ++n) acc[a][b][m][n] = (f32x4){0.f, 0.f, 0.f, 0.f};
    bf16x8 At[4][2], B0[2][2], B1[2][2];
    const char* cA = (const char*)g.A + (size_t)cur.pm * tstep; const char* cB = (const char*)g.Bt + (size_t)cur.pn * tstep;
    S.a_ready(cur);
    PG8_STAGE(PG8_SB(0, 0), cB, voffB); PG8_STAGE(PG8_SA(0, 0), cA, voffA); PG8_STAGE(PG8_SB(0, 1), cB + hstep, voffB); PG8_STAGE(PG8_SA(0, 1), cA + hstep, voffA);
    if (wr == 1) PG8_BAR;
    PG8_WAIT_V(4); PG8_BAR;
    PG8_STAGE(PG8_SB(1, 0), cB + kstep, voffB); PG8_STAGE(PG8_SA(1, 0), cA + kstep, voffA); PG8_STAGE(PG8_SB(1, 1), cB + hstep + kstep, voffB);
    PG8_WAIT_V(6); PG8_BAR;
    PG8_STAMP();
    for (;;) {
        const bool has_next = S.next(ui + 1, nxt);
        const char* nA = has_next ? (const char*)g.A + (size_t)nxt.pm * tstep : cA; const char* nB = has_next ? (const char*)g.Bt + (size_t)nxt.pn * tstep : cB;
        for (int t = 0; t < nt; t += 2) {
            const bool last = (t == nt - 2);
            const char* a1 = cA + (size_t)(t + 1) * kstep;
            const char* a2 = last ? nA : cA + (size_t)(t + 2) * kstep; const char* b2 = last ? nB : cB + (size_t)(t + 2) * kstep;
            const char* a3 = a2 + kstep; const char* b3 = b2 + kstep;
            if (last && has_next) S.a_ready(nxt);
            PG8_LDB(B0, 0, 0); PG8_SCHED; PG8_LDA(At, 0, 0); PG8_STAGE(PG8_SA(1, 1), a1 + hstep, voffA);
            PG8_WAIT_L(8); PG8_BAR; PG8_WAIT_L(0); PG8_MMA(0, 0, At, B0); PG8_BAR; PG8_SCHED;
            PG8_LDB(B1, 0, 1); PG8_STAGE(PG8_SB(0, 0), b2, voffB);
            PG8_BAR; PG8_WAIT_L(0); PG8_MMA(0, 1, At, B1); PG8_BAR;
            PG8_LDA(At, 0, 1); PG8_STAGE(PG8_SA(0, 0), a2, voffA);
            PG8_BAR; PG8_WAIT_L(0); PG8_MMA(1, 0, At, B0); PG8_BAR; PG8_SCHED;
            PG8_STAGE(PG8_SB(0, 1), b2 + hstep, voffB);
            PG8_WAIT_V(6); PG8_BAR; PG8_MMA(1, 1, At, B1); PG8_BAR;
            PG8_LDB(B0, 1, 0); PG8_SCHED; PG8_LDA(At, 1, 0); PG8_STAGE(PG8_SA(0, 1), a2 + hstep, voffA);
            PG8_WAIT_L(8); PG8_BAR; PG8_WAIT_L(0); PG8_MMA(0, 0, At, B0); PG8_BAR; PG8_SCHED;
            PG8_LDB(B1, 1, 1); PG8_STAGE(PG8_SB(1, 0), b3, voffB);
            PG8_BAR; PG8_WAIT_L(0); PG8_MMA(0, 1, At, B1); PG8_BAR;
            PG8_LDA(At, 1, 1); PG8_STAGE(PG8_SA(1, 0), a3, voffA);
            PG8_BAR; PG8_WAIT_L(0); PG8_MMA(1, 0, At, B0); PG8_BAR; PG8_SCHED;
            PG8_STAGE(PG8_SB(1, 1), b3 + hstep, voffB);
            PG8_WAIT_V(6); PG8_BAR; PG8_MMA(1, 1, At, B1); PG8_BAR;
        }
        PG8_STAMP();
        if constexpr (!Epi::AFTER_DRAIN) { E(acc, cur, wr, wc, fr, fq); S.done(cur); }
        PG8_STAMP();
        if (!has_next) break;
#pragma unroll
        for (int a = 0; a < 2; ++a)
#pragma unroll
            for (int b = 0; b < 2; ++b)
#pragma unroll
                for (int m = 0; m < 4; ++m)
#pragma unroll
                    for (int n = 0; n < 2; ++n) acc[a][b][m][n] = (f32x4){0.f, 0.f, 0.f, 0.f};
        cur = nxt; cA = nA; cB = nB; ++ui;
    }
    PG8_WAIT_V(0);
    if (wr == 0) PG8_BAR;
    PG8_BAR;
    if constexpr (Epi::AFTER_DRAIN) { E.fused(acc, cur, wr, wc, fr, fq, lds, wid, lane); S.done(cur); }
    PG8_STAMP();
    if (STAMP && wid == 0) { stamps[lane] = lane < nts ? (((unsigned long long)(unsigned)ts_hi << 32) | (unsigned)ts_lo) : 0ull;
        if (lane == 62) stamps[62] = rt_entry; if (lane == 63) stamps[63] = (unsigned long long)wall_clock64(); }
#undef PG8_STAMP
#undef PG8_SA
#undef PG8_SB
#undef PG8_STAGE
#undef PG8_LDA
#undef PG8_LDB
#undef PG8_MMA
#undef PG8_WAIT_V
#undef PG8_WAIT_L
#undef PG8_BAR
#undef PG8_SCHED
}
}

#define LAS __attribute__((address_space(3)))
typedef unsigned short bf16_t;
typedef short bf16x8 __attribute__((ext_vector_type(8)));
typedef float f32x4 __attribute__((ext_vector_type(4)));
typedef unsigned u32x4 __attribute__((ext_vector_type(4)));
typedef unsigned u32x2 __attribute__((ext_vector_type(2)));

constexpr int MP = 16384, MS = 512, MT = MP + MS;
constexpr int DM = 1024, DFF = 4096;
constexpr int ABN = 3072, ABSRC = 3096, SSDN = 5120, SSDSRC = 5152;
constexpr int NITEM = 1536;
constexpr float LN_EPS = 1e-5f;
constexpr float DN_ALPHA = 1.6817928305074290861f;

constexpr size_t MiB = (size_t)1 << 20;
constexpr size_t WS_CTL = 0, CTL_BYTES = 16384;
constexpr size_t WS_WABIN = 1 * MiB, WS_WABG = 13 * MiB, WS_WABOUT = 14 * MiB, WS_WSSDIN = 18 * MiB, WS_WSSDG = 38 * MiB, WS_WSSDOUT = 39 * MiB;
constexpr size_t WS_W1 = 47 * MiB, WS_W2 = 79 * MiB;
constexpr size_t WS_XF = 112 * MiB, WS_XB = 178 * MiB, WS_Y = 211 * MiB, WS_P = 277 * MiB  , WS_MIX = 442 * MiB, WS_YG = 508 * MiB;
constexpr size_t WS_GT = 574 * MiB, WS_SQ = 577 * MiB, WS_DCT = 580 * MiB, WS_CINT = 676 * MiB, WS_ACUM = 724 * MiB, WS_DN = 748 * MiB, WS_NIN = 749 * MiB, WS_DEC = 750 * MiB, WS_SCAL = 751 * MiB;
constexpr size_t WS_CONVB = WS_DCT;
constexpr size_t WS_CS = 752 * MiB;
constexpr size_t WS_DTB = 756 * MiB;
constexpr size_t WS_END = 760 * MiB;

constexpr size_t O_YP = 0, O_YS = 16777216, O_PC = O_YS + 524288, O_PN = O_PC + 524288, O_PM = O_PN + 4096, O_PS = O_PM + 64, O_PH = O_PS + 524288, O_PCV = O_PH + 4194304;
constexpr size_t O_SC = O_PCV + 147456, O_SN = O_SC + 8388608, O_SM = O_SN + 65536, O_SS = O_SM + 1024, O_SH = O_SS + 8388608, O_SCV = O_SH + 67108864, O_END = O_SCV + 2359296;

constexpr int LDS_BAR_OFF = 156672, LDS_BYTES = 156672 + 256;

struct Params { const float* in[30]; float* out; unsigned char* ws; };

#define RAW_BAR() do { asm volatile("s_waitcnt lgkmcnt(0)" ::: "memory"); __builtin_amdgcn_s_barrier(); asm volatile("" ::: "memory"); } while (0)
__device__ __forceinline__ int otid() { int t = threadIdx.x; asm volatile("" : "+v"(t)); return t; }
__device__ __forceinline__ float bf2f(bf16_t v) { return __uint_as_float(((unsigned)v) << 16); }
__device__ __forceinline__ unsigned pk2(float lo, float hi) { unsigned r; asm("v_cvt_pk_bf16_f32 %0, %1, %2" : "=v"(r) : "v"(lo), "v"(hi)); return r; }
__device__ __forceinline__ bf16_t f2bf(float f) { return (bf16_t)(pk2(f, f) & 0xffffu); }
__device__ __forceinline__ float bfe(const u32x4& v, int e) { const unsigned w = v[e >> 1]; return __uint_as_float((e & 1) ? (w & 0xffff0000u) : (w << 16)); }
__device__ __forceinline__ bf16_t bfr(const u32x4& v, int e) { const unsigned w = v[e >> 1]; return (bf16_t)((e & 1) ? (w >> 16) : (w & 0xffffu)); }
__device__ __forceinline__ float logsig(float x) { return fminf(x, 0.f) - log1pf(__expf(-fabsf(x))); }
__device__ __forceinline__ float softplusf(float x) { return fmaxf(x, 0.f) + log1pf(__expf(-fabsf(x))); }
__device__ __forceinline__ float sigm(float x) { return __builtin_amdgcn_rcpf(1.f + __expf(-x)); }
__device__ __forceinline__ float wave_sum(float v) {
#pragma unroll
    for (int o = 32; o >= 1; o >>= 1) v += __shfl_xor(v, o);
    return v; }
__device__ __forceinline__ float wave_max(float v) {
#pragma unroll
    for (int o = 32; o >= 1; o >>= 1) v = fmaxf(v, __shfl_xor(v, o));
    return v; }
__device__ __forceinline__ float wave_scan_add(float v, int lane) {
#pragma unroll
    for (int o = 1; o < 64; o <<= 1) { const float t = __shfl_up(v, o); if (lane >= o) v += t; }
    return v; }
__device__ __forceinline__ float wave_scan_max(float v, int lane) {
#pragma unroll
    for (int o = 1; o < 64; o <<= 1) { const float t = __shfl_up(v, o); if (lane >= o) v = fmaxf(v, t); }
    return v; }
__device__ __forceinline__ f32x4 mma(bf16x8 a, bf16x8 b, f32x4 c) { return __builtin_amdgcn_mfma_f32_16x16x32_bf16(a, b, c, 0, 0, 0); }
__device__ __forceinline__ bf16x8 ldsfrag(const LAS bf16_t* base, int row0, int ld, int k0, int lane) {
    return *(const LAS bf16x8*)(base + (row0 + (lane & 15)) * ld + k0 + (lane >> 4) * 8); }

__device__ __forceinline__ bf16x8 ldsfrag_swz(const LAS bf16_t* base, int row0, int ld, int k0, int lane) {
    const int row = row0 + (lane & 15), k = k0 + (lane >> 4) * 8;
    return *(const LAS bf16x8*)(base + row * ld + (k ^ (((row >> 3) & 7) << 3))); }

#define XB_TMO      128
#define XB_XCNT(j)  (256  + 64 * (j))
#define XB_XSUB(j)  (1280 + 64 * (j))
#define XB_XGEN(j)  (2304 + 64 * (j))
#define XB_TOP      3328
#define XB_TOPGEN   3392
#define XCD_BAR_WORDS 3456
#define XB_SPIN_CAP (1u << 18)
__device__ __forceinline__ unsigned xb_ld(unsigned* p)              { return __hip_atomic_load(p, __ATOMIC_RELAXED, __HIP_MEMORY_SCOPE_AGENT); }
__device__ __forceinline__ unsigned xb_add(unsigned* p, unsigned v) { return __hip_atomic_fetch_add(p, v, __ATOMIC_RELAXED, __HIP_MEMORY_SCOPE_AGENT); }
__device__ __forceinline__ unsigned xb_xcc_id() { return (unsigned)__builtin_amdgcn_s_getreg((3 << 11) | 20) & 0xFu; }
#define XB_SPIN(cond, bar) do { unsigned _sp = 0; while (cond) { __builtin_amdgcn_s_sleep(1); \
    if ((++_sp & 255u) == 0u) { if (xb_ld(&(bar)[XB_TMO])) break; if (_sp > XB_SPIN_CAP) { atomicAdd(&(bar)[XB_TMO], 1u); break; } } } } while (0)
struct XcdBarrier { unsigned* bar; unsigned x; volatile LAS unsigned* st; };
__device__ __forceinline__ XcdBarrier xcd_barrier_post(unsigned* bar, volatile LAS unsigned* st) {
    XcdBarrier b; b.bar = bar; b.x = xb_xcc_id(); b.st = st;
    if (threadIdx.x == 0) (void)xb_add(&bar[XB_XCNT(b.x)], 1u);
    return b;
}
__device__ __forceinline__ void xcd_barrier_complete(unsigned* bar, unsigned x, unsigned& nloc, unsigned& nx) {
    const unsigned G = gridDim.x * gridDim.y * gridDim.z;
    unsigned sum, cnt, mine, sp = 0u;
    for (;;) {
        sum = 0u; cnt = 0u; mine = 0u;
#pragma unroll
        for (unsigned j = 0; j < 16; ++j) { const unsigned c = xb_ld(&bar[XB_XCNT(j)]); sum += c; cnt += (c > 0u) ? 1u : 0u; mine = (j == x) ? c : mine; }
        if (sum == G) break;
        __builtin_amdgcn_s_sleep(1);
        if ((++sp & 255u) == 0u) { if (xb_ld(&bar[XB_TMO])) break; if (sp > XB_SPIN_CAP) { atomicAdd(&bar[XB_TMO], 1u); break; } }
    }
    nloc = mine > 0u ? mine : 1u; nx = cnt > 0u ? cnt : 1u;
}
__device__ __forceinline__ void xcd_barrier(const XcdBarrier& b) {
    asm volatile("s_waitcnt vmcnt(0)" ::: "memory");
    __syncthreads();
    if (threadIdx.x == 0) {
        unsigned* bar = b.bar;
        __builtin_amdgcn_s_waitcnt(0);
        unsigned nloc = b.st[0], nx = b.st[1];
        if (nloc == 0u) { xcd_barrier_complete(bar, b.x, nloc, nx); b.st[0] = nloc; b.st[1] = nx; }
        const unsigned old = xb_add(&bar[XB_XSUB(b.x)], 1u);
        const unsigned gen = old / nloc;
        if (old + 1u == (gen + 1u) * nloc) {
            __builtin_amdgcn_fence(__ATOMIC_RELEASE, "agent");
            asm volatile("s_waitcnt vmcnt(0)" ::: "memory");
            const unsigned og = xb_add(&bar[XB_TOP], 1u);
            const unsigned tg = og / nx;
            if (og + 1u == (tg + 1u) * nx) xb_add(&bar[XB_TOPGEN], 1u);
            else XB_SPIN(xb_ld(&bar[XB_TOPGEN]) == tg, bar);
            __builtin_amdgcn_fence(__ATOMIC_ACQUIRE, "agent");
            xb_add(&bar[XB_XGEN(b.x)], 1u);
            asm volatile("s_waitcnt vmcnt(0)" ::: "memory");
        } else {
            XB_SPIN(xb_ld(&bar[XB_XGEN(b.x)]) == gen, bar);
            __builtin_amdgcn_fence(__ATOMIC_ACQUIRE, "agent");
            asm volatile("s_waitcnt vmcnt(0)" ::: "memory");
        }
    }
    __syncthreads();
}

__device__ __forceinline__ void p0_prologue(const Params& P, LAS unsigned char* lds) {
    const int tid = otid();
    LAS float* tileb = (LAS float*)lds;
#define P0_DECODE(t, src_, dst_, K_, ldS_, k0_, n0_, sc_) do { int r_, sp_ = 0; \
        if ((t) < 768)       { const int j_ = (t) / 384; r_ = (t) % 384; src_ = P.in[8] + (size_t)j_ * 1024 * ABSRC; ldS_ = ABSRC; K_ = 1024; dst_ = (bf16_t*)(P.ws + WS_WABIN) + (size_t)j_ * ABN * 1024; sp_ = 1; } \
        else if ((t) < 1024) { const int q_ = (t) - 768, j_ = q_ / 128; r_ = q_ % 128; src_ = P.in[15] + (size_t)j_ * 1024 * 1024; ldS_ = 1024; K_ = 1024; dst_ = (bf16_t*)(P.ws + WS_WABOUT) + (size_t)j_ * 1024 * 1024; } \
        else if ((t) < 2304) { const int q_ = (t) - 1024, j_ = q_ / 640; r_ = q_ % 640; src_ = P.in[16] + (size_t)j_ * 1024 * SSDSRC; ldS_ = SSDSRC; K_ = 1024; dst_ = (bf16_t*)(P.ws + WS_WSSDIN) + (size_t)j_ * SSDN * 1024; } \
        else if ((t) < 2816) { const int q_ = (t) - 2304, j_ = q_ / 256; r_ = q_ % 256; src_ = P.in[23] + (size_t)j_ * 2048 * 1024; ldS_ = 1024; K_ = 2048; dst_ = (bf16_t*)(P.ws + WS_WSSDOUT) + (size_t)j_ * 1024 * 2048; } \
        else if ((t) < 4864) { const int q_ = (t) - 2816, l_ = q_ / 512; r_ = q_ % 512; src_ = P.in[24] + (size_t)l_ * 1024 * 4096; ldS_ = 4096; K_ = 1024; dst_ = (bf16_t*)(P.ws + WS_W1) + (size_t)l_ * 4096 * 1024; } \
        else                 { const int q_ = (t) - 4864, l_ = q_ / 512; r_ = q_ % 512; src_ = P.in[25] + (size_t)l_ * 4096 * 1024; ldS_ = 1024; K_ = 4096; dst_ = (bf16_t*)(P.ws + WS_W2) + (size_t)l_ * 1024 * 4096; } \
        const int nkt_ = K_ >> 7; k0_ = (r_ % nkt_) * 128; n0_ = (r_ / nkt_) * 64; sc_ = n0_ + ((sp_ && n0_ >= 1536) ? 8 : 0); } while (0)
    {
        constexpr int NT0 = 6912;
        const int rr = tid >> 4, c4 = (tid & 15) * 4;
        const int G2 = gridDim.x;
        f32x4 va[4], vb[4];
#pragma unroll
        for (int q = 0; q < 4; ++q) { va[q] = (f32x4){0.f, 0.f, 0.f, 0.f}; vb[q] = (f32x4){0.f, 0.f, 0.f, 0.f}; }
        const float* src; int ldS, sc;
        bf16_t* dstA = nullptr; int KA = 0, k0A = 0, n0A = 0; bf16_t* dstB = nullptr; int KB = 0, k0B = 0, n0B = 0;
        int tA = blockIdx.x, tB = blockIdx.x + G2;
        if (tA < NT0) { P0_DECODE(tA, src, dstA, KA, ldS, k0A, n0A, sc);
#pragma unroll
            for (int q = 0; q < 4; ++q) va[q] = *(const f32x4*)(src + (size_t)(k0A + rr + 32 * q) * ldS + sc + c4); }
        if (tB < NT0) { P0_DECODE(tB, src, dstB, KB, ldS, k0B, n0B, sc);
#pragma unroll
            for (int q = 0; q < 4; ++q) vb[q] = *(const f32x4*)(src + (size_t)(k0B + rr + 32 * q) * ldS + sc + c4); }
#define P0_STEP(V, DST, KK, K0, N0, TT, BUF) do { \
            LAS float* tile_ = tileb + (BUF) * (128 * 65); \
            _Pragma("unroll") for (int q = 0; q < 4; ++q) { const int k_ = rr + 32 * q; tile_[k_ * 65 + c4 + 0] = V[q][0]; tile_[k_ * 65 + c4 + 1] = V[q][1]; tile_[k_ * 65 + c4 + 2] = V[q][2]; tile_[k_ * 65 + c4 + 3] = V[q][3]; } \
            bf16_t* cdst_ = DST; const int cK_ = KK, ck0_ = K0, cn0_ = N0; \
            TT += 2 * G2; \
            if (TT < NT0) { P0_DECODE(TT, src, DST, KK, ldS, K0, N0, sc); \
                _Pragma("unroll") for (int q = 0; q < 4; ++q) V[q] = *(const f32x4*)(src + (size_t)(K0 + rr + 32 * q) * ldS + sc + c4); } \
            __syncthreads(); \
            { const int n_ = tid >> 3, kv_ = (tid & 7) * 16; u32x4 w0_, w1_; \
              w0_.x = pk2(tile_[(kv_ + 0) * 65 + n_], tile_[(kv_ + 1) * 65 + n_]); w0_.y = pk2(tile_[(kv_ + 2) * 65 + n_], tile_[(kv_ + 3) * 65 + n_]); \
              w0_.z = pk2(tile_[(kv_ + 4) * 65 + n_], tile_[(kv_ + 5) * 65 + n_]); w0_.w = pk2(tile_[(kv_ + 6) * 65 + n_], tile_[(kv_ + 7) * 65 + n_]); \
              w1_.x = pk2(tile_[(kv_ + 8) * 65 + n_], tile_[(kv_ + 9) * 65 + n_]); w1_.y = pk2(tile_[(kv_ + 10) * 65 + n_], tile_[(kv_ + 11) * 65 + n_]); \
              w1_.z = pk2(tile_[(kv_ + 12) * 65 + n_], tile_[(kv_ + 13) * 65 + n_]); w1_.w = pk2(tile_[(kv_ + 14) * 65 + n_], tile_[(kv_ + 15) * 65 + n_]); \
              bf16_t* dp_ = cdst_ + (size_t)(cn0_ + n_) * cK_ + ck0_ + kv_; *(u32x4*)dp_ = w0_; *(u32x4*)(dp_ + 8) = w1_; } } while (0)
#pragma unroll 1
        while (tA < NT0) {
            P0_STEP(va, dstA, KA, k0A, n0A, tA, 0);
            if (tB < NT0) P0_STEP(vb, dstB, KB, k0B, n0B, tB, 1);
        }
#undef P0_STEP
    }
#undef P0_DECODE
    const int gtid = blockIdx.x * 512 + tid, gsz = gridDim.x * 512;
    for (int idx = gtid; idx < 4 * 32 * 1024; idx += gsz) {
        const int which = idx >> 15, n = (idx >> 10) & 31, k = idx & 1023; float v = 0.f;
        if (which < 2) { const int col = n < 4 ? 1536 + n : (n < 8 ? 1540 + (n - 4) : (n < 24 ? 3080 + (n - 8) : -1));
            if (col >= 0) v = P.in[8][((size_t)which * 1024 + k) * ABSRC + col];
            ((bf16_t*)(P.ws + WS_WABG))[(size_t)which * 32768 + n * 1024 + k] = f2bf(v); }
        else { const int j = which - 2; v = P.in[16][((size_t)j * 1024 + k) * SSDSRC + 5120 + n];
            ((bf16_t*)(P.ws + WS_WSSDG))[(size_t)j * 32768 + n * 1024 + k] = f2bf(v); }
    }
    { const f32x4* xp = (const f32x4*)P.in[0]; const f32x4* xs = (const f32x4*)P.in[1]; u32x2* XB = (u32x2*)(P.ws + WS_XB);
      for (int idx0 = gtid; idx0 < MT * 256; idx0 += 4 * gsz) { f32x4 v[4];
#pragma unroll
          for (int q = 0; q < 4; ++q) { const int idx = idx0 + q * gsz; if (idx < MT * 256) v[q] = idx < MP * 256 ? xp[idx] : xs[idx - MP * 256]; }
#pragma unroll
          for (int q = 0; q < 4; ++q) { const int idx = idx0 + q * gsz; if (idx < MT * 256) { u32x2 w; w.x = pk2(v[q][0], v[q][1]); w.y = pk2(v[q][2], v[q][3]); XB[idx] = w; } } } }
}

__device__ __forceinline__ void gates_phase(LAS unsigned char* lds, const bf16_t* XB, const bf16_t* Gt, float* GT) {
    const int tid = otid(), lane = tid & 63, wave = __builtin_amdgcn_readfirstlane(tid >> 6);
    const int gw = blockIdx.x * 8 + wave, nw = gridDim.x * 8;
    LAS bf16_t* stg = (LAS bf16_t*)(lds + wave * 6912);
    const int lr = lane >> 3, lc = (lane & 7) * 8;
    for (int task = gw; task < MT / 16; task += nw) {
        const int m0 = task * 16;
        f32x4 a0 = {0.f, 0.f, 0.f, 0.f}, a1 = {0.f, 0.f, 0.f, 0.f};
        const bf16_t* ap = XB + (size_t)(m0 + lr) * 1024 + lc;
        const bf16_t* bp = Gt + (size_t)lr * 1024 + lc;
        u32x4 g[6];
#pragma unroll
        for (int i = 0; i < 2; ++i) g[i] = *(const u32x4*)(ap + (size_t)(i * 8) * 1024);
#pragma unroll
        for (int i = 0; i < 4; ++i) g[2 + i] = *(const u32x4*)(bp + (size_t)(i * 8) * 1024);
#pragma unroll 1
        for (int kb = 0; kb < 16; ++kb) {
#pragma unroll
            for (int i = 0; i < 6; ++i) *(LAS u32x4*)(stg + (i * 8 + lr) * 72 + lc) = g[i];
            if (kb + 1 < 16) {
#pragma unroll
                for (int i = 0; i < 2; ++i) g[i] = *(const u32x4*)(ap + (size_t)(i * 8) * 1024 + (kb + 1) * 64);
#pragma unroll
                for (int i = 0; i < 4; ++i) g[2 + i] = *(const u32x4*)(bp + (size_t)(i * 8) * 1024 + (kb + 1) * 64);
            }
#pragma unroll
            for (int q = 0; q < 2; ++q) { const bf16x8 a = ldsfrag(stg, 0, 72, q * 32, lane), b0 = ldsfrag(stg, 16, 72, q * 32, lane), b1 = ldsfrag(stg, 32, 72, q * 32, lane);
                a0 = mma(a, b0, a0); a1 = mma(a, b1, a1); }
        }
#pragma unroll
        for (int r = 0; r < 4; ++r) { const int row = m0 + (lane >> 4) * 4 + r; GT[(size_t)(lane & 15) * MT + row] = a0[r]; GT[(size_t)(16 + (lane & 15)) * MT + row] = a1[r]; }
    }
    __syncthreads();
}

__device__ __forceinline__ void ln_phase(const bf16_t* Y, const float* g, const float* bta, float* OUT, bf16_t* XB) {
    const int tid = otid(), lane = tid & 63, wave = tid >> 6;
    const int gw = blockIdx.x * 8 + wave, nw = gridDim.x * 8;
    const int sub = lane >> 4, l16 = lane & 15;
    for (int row0 = gw * 4; row0 < MT; row0 += nw * 4) {
        const int row = row0 + sub;
        const bf16_t* yr = Y + (size_t)row * 1024;
        u32x4 yv[8]; float s = 0.f;
#pragma unroll
        for (int k = 0; k < 8; ++k) yv[k] = *(const u32x4*)(yr + (l16 + 16 * k) * 8);
#pragma unroll
        for (int k = 0; k < 8; ++k)
#pragma unroll
            for (int e = 0; e < 8; ++e) s += bfe(yv[k], e);
        s += __shfl_xor(s, 1); s += __shfl_xor(s, 2); s += __shfl_xor(s, 4); s += __shfl_xor(s, 8);
        const float mean = s * (1.f / 1024.f); float q = 0.f;
#pragma unroll
        for (int k = 0; k < 8; ++k)
#pragma unroll
            for (int e = 0; e < 8; ++e) { const float d = bfe(yv[k], e) - mean; q += d * d; }
        q += __shfl_xor(q, 1); q += __shfl_xor(q, 2); q += __shfl_xor(q, 4); q += __shfl_xor(q, 8);
        const float rstd = rsqrtf(q * (1.f / 1024.f) + LN_EPS);
#pragma unroll
        for (int k = 0; k < 8; ++k) { const int col = (l16 + 16 * k) * 8;
            const f32x4 g0 = *(const f32x4*)(g + col), g1 = *(const f32x4*)(g + col + 4), b0 = *(const f32x4*)(bta + col), b1 = *(const f32x4*)(bta + col + 4);
            f32x4 o0, o1;
#pragma unroll
            for (int e = 0; e < 4; ++e) { o0[e] = (bfe(yv[k], e) - mean) * rstd * g0[e] + b0[e]; o1[e] = (bfe(yv[k], 4 + e) - mean) * rstd * g1[e] + b1[e]; }
            if (OUT) { *(f32x4*)(OUT + (size_t)row * 1024 + col) = o0; *(f32x4*)(OUT + (size_t)row * 1024 + col + 4) = o1; }
            u32x4 w; w.x = pk2(o0[0], o0[1]); w.y = pk2(o0[2], o0[3]); w.z = pk2(o1[0], o1[1]); w.w = pk2(o1[2], o1[3]);
            *(u32x4*)(XB + (size_t)row * 1024 + col) = w; }
    }
}

struct AbItem { int samp, b, h, c, m0, nvalid; };
__device__ __forceinline__ AbItem ab_decode(int i) {
    AbItem t; t.samp = i >= 1024;
    if (!t.samp) { t.b = i >> 7; t.h = (i >> 5) & 3; t.c = i & 31; t.m0 = t.b * 2048 + t.c * 64; t.nvalid = 64; }
    else { const int r = i - 1024; t.b = r >> 2; t.h = r & 3; t.c = 0; t.m0 = MP + t.b * 4; t.nvalid = 4; }
    return t;
}
__device__ __forceinline__ void write_vt(LAS bf16_t* VT, const u32x4& a, const u32x4& b, int tid) {
    const int c16 = tid & 15, s0 = (2 * (tid >> 4)) ^ ((c16 & 7) << 3);
#pragma unroll
    for (int e = 0; e < 8; ++e) *(LAS unsigned*)(VT + (c16 * 8 + e) * 72 + s0) = (unsigned)bfr(a, e) | ((unsigned)bfr(b, e) << 16);
}

template <int TYPE> __device__ __forceinline__ void ab_delta_item(const Params& P, LAS unsigned char* lds, int j, int i) {
    const int tid = otid(), lane = tid & 63, wave = __builtin_amdgcn_readfirstlane(tid >> 6);
    const AbItem it = ab_decode(i);
    const int b = it.b, h = it.h, c = it.c, m0 = it.m0, nvalid = it.nvalid;
    LAS bf16_t* KT = (LAS bf16_t*)lds; LAS bf16_t* VT = (LAS bf16_t*)(lds + 9216);
    const bf16_t* Pb = (const bf16_t*)(P.ws + WS_P);
    const float* GT = (const float*)(P.ws + WS_GT);
    const int kcol = TYPE == 0 ? 256 + h * 64 : 1792 + h * 64, vcol = TYPE == 0 ? 512 + h * 128 : 2048 + h * 128;
    const int ls = tid >> 3, ld8 = (tid & 7) * 8, lv16 = (tid & 7) * 16;
    u32x4 kv = {0u, 0u, 0u, 0u}, va = {0u, 0u, 0u, 0u}, vb = {0u, 0u, 0u, 0u};
    if (ls < nvalid) { const bf16_t* rowp = Pb + (size_t)(m0 + ls) * ABN; kv = *(const u32x4*)(rowp + kcol + ld8); }
    { const int vr = 2 * (tid >> 4), vc = (tid & 15) * 8;
      if (vr < nvalid) va = *(const u32x4*)(Pb + (size_t)(m0 + vr) * ABN + vcol + vc);
      if (vr + 1 < nvalid) vb = *(const u32x4*)(Pb + (size_t)(m0 + vr + 1) * ABN + vcol + vc); }
    if (TYPE == 0) {
        LAS float* bt = (LAS float*)(lds + 27648); LAS float* igt = bt + 64; LAS float* scb = bt + 128; LAS float* sca = bt + 160;
        const float igb = P.in[9][j * 4 + h], fgb = P.in[10][j * 4 + h];
        float mprev = it.samp ? P.in[4][(j * 128 + b) * 4 + h] : 0.f;
        const bool valid = lane < nvalid;
        float pf[4], pi[4];
#pragma unroll
        for (int q = 0; q < 4; ++q) { const int cc = wave + 8 * q; pf[q] = 0.f; pi[q] = 0.f;
            if (cc <= c && valid) { const int row = (it.samp ? m0 : b * 2048 + cc * 64) + lane; pf[q] = GT[(size_t)(4 + h) * MT + row]; pi[q] = GT[(size_t)h * MT + row]; } }
#pragma unroll
        for (int q = 0; q < 4; ++q) { const int cc = wave + 8 * q;
            if (cc <= c) {
                const float lf = valid ? logsig(pf[q] + fgb) : 0.f, ig = valid ? pi[q] + igb : -INFINITY;
                const float bs = wave_scan_add(lf, lane); const float am = wave_max(ig - bs);
                if (cc == c) { bt[lane] = bs; igt[lane] = ig; }
                if (lane == 63) scb[cc] = bs;
                if (lane == 0) sca[cc] = am;
            } }
        __syncthreads();
        for (int cc = 0; cc < c; ++cc) mprev = scb[cc] + fmaxf(mprev, sca[cc]);
        const float bL = scb[c], aL = sca[c]; const float mL = bL + fmaxf(mprev, aL); const float wL0 = __expf(bL + mprev - mL);
        { float wl = 0.f; if (ls < nvalid) wl = 0.125f * __expf(bL - bt[ls] + igt[ls] - mL);
#pragma unroll
          for (int e = 0; e < 8; ++e) KT[(ld8 + e) * 72 + (ls ^ ld8)] = f2bf(bfe(kv, e) * wl); }
        if (tid == 0) { float* sc = (float*)(P.ws + WS_SCAL) + (size_t)i * 4; sc[0] = mprev; sc[1] = wL0; sc[2] = mL;
            if (it.samp) P.out[O_SM + (j * 128 + b) * 4 + h] = mL; else if (c == 31) P.out[O_PM + (j * 8 + b) * 4 + h] = mL; }
    } else {
        LAS float* gaL = (LAS float*)(lds + 28672); LAS float* Ac = (LAS float*)(lds + 32768); LAS float* seg = (LAS float*)(lds + 49408);
        const int dk = tid & 63, sg = tid >> 6;
        float g2v[2];
#pragma unroll
        for (int q = 0; q < 2; ++q) { const int idx = tid + q * 512, r = idx >> 6, s = idx & 63; g2v[q] = (s < nvalid) ? GT[(size_t)(8 + r) * MT + m0 + s] : 0.f; }
        float wcv[16];
#pragma unroll
        for (int r = 0; r < 16; ++r) wcv[r] = P.in[12][(size_t)(j * 16 + r) * 256 + h * 64 + dk];
        const float bias = P.in[13][j * 256 + h * 64 + dk];
        gaL[tid] = g2v[0]; gaL[tid + 512] = g2v[1];
        __syncthreads();
        float loc[8]; float run = 0.f;
#pragma unroll
        for (int ss = 0; ss < 8; ++ss) { const int s = sg * 8 + ss; float la = 0.f;
            if (s < nvalid) { float z = bias;
#pragma unroll
                for (int r = 0; r < 16; ++r) z += gaL[r * 64 + s] * wcv[r];
                la = logsig(z) * (1.f / 16.f); }
            run += la; loc[ss] = run; }
        seg[sg * 64 + dk] = run;
        __syncthreads();
        float off = 0.f;
#pragma unroll
        for (int g2 = 0; g2 < 8; ++g2) off += (g2 < sg) ? seg[g2 * 64 + dk] : 0.f;
        float* acg = (float*)(P.ws + WS_ACUM) + (size_t)i * 4096;
#pragma unroll
        for (int ss = 0; ss < 8; ++ss) { const int s = sg * 8 + ss; const float a = loc[ss] + off; Ac[s * 65 + dk] = a; acg[s * 64 + dk] = a; }
        __syncthreads();
#pragma unroll
        for (int e = 0; e < 8; ++e) { const int d = ld8 + e; const float wgt = __expf(Ac[63 * 65 + d] - Ac[ls * 65 + d]); KT[d * 72 + (ls ^ ld8)] = f2bf(bfe(kv, e) * wgt); }
        if (tid < 64) ((float*)(P.ws + WS_DEC))[(size_t)i * 64 + tid] = __expf(Ac[63 * 65 + tid]);
    }
    write_vt(VT, va, vb, tid);
    __syncthreads();
    f32x4 acc[4];
#pragma unroll
    for (int jj = 0; jj < 4; ++jj) acc[jj] = (f32x4){0.f, 0.f, 0.f, 0.f};
#pragma unroll
    for (int ks = 0; ks < 2; ++ks) { const bf16x8 a = ldsfrag_swz(VT, wave * 16, 72, ks * 32, lane);
#pragma unroll
        for (int jj = 0; jj < 4; ++jj) { const bf16x8 bb = ldsfrag_swz(KT, jj * 16, 72, ks * 32, lane); acc[jj] = mma(a, bb, acc[jj]); } }
    float* dct = (float*)(P.ws + WS_DCT) + (size_t)(TYPE * NITEM + i) * 8192;
#pragma unroll
    for (int jj = 0; jj < 4; ++jj)
#pragma unroll
        for (int r = 0; r < 4; ++r) dct[(wave * 16 + (lane >> 4) * 4 + r) * 64 + jj * 16 + (lane & 15)] = acc[jj][r];
    if (TYPE == 0 && tid < 64) { float sa = 0.f;
#pragma unroll 8
        for (int s = 0; s < 64; s += 8) { const u32x4 kk = *(const LAS u32x4*)(KT + tid * 72 + s);
#pragma unroll
            for (int e = 0; e < 8; ++e) sa += bfe(kk, e); }
        ((float*)(P.ws + WS_DN))[(size_t)i * 64 + tid] = sa; }
    __syncthreads();
}

__device__ __forceinline__ void ab_scan_phase(const Params& P, LAS unsigned char* lds, int j) {
    const int tid = otid();
    const float* DCT = (const float*)(P.ws + WS_DCT); bf16_t* CINT = (bf16_t*)(P.ws + WS_CINT);
    const float* SCAL = (const float*)(P.ws + WS_SCAL); const float* DEC = (const float*)(P.ws + WS_DEC);
    const float* DN = (const float*)(P.ws + WS_DN); float* NIN = (float*)(P.ws + WS_NIN);
    for (int task = blockIdx.x; task < 256 + 1024; task += gridDim.x) {
        if (task < 256) {
            const int type = task >> 7, seq = (task >> 2) & 31, q = task & 3, b = seq >> 2, h = seq & 3;
            const int e = q * 2048 + tid * 4;
            f32x4 st = {0.f, 0.f, 0.f, 0.f};
#pragma unroll 8
            for (int c = 0; c < 32; ++c) { const int i = seq * 32 + c; const size_t base = (size_t)(type * NITEM + i) * 8192 + e;
                const f32x4 d = *(const f32x4*)(DCT + base);
                f32x4 dec; if (type == 0) { const float w = SCAL[i * 4 + 1]; dec = (f32x4){w, w, w, w}; } else dec = *(const f32x4*)(DEC + (size_t)i * 64 + (e & 63));
                u32x2 w2; w2.x = pk2(st[0], st[1]); w2.y = pk2(st[2], st[3]); *(u32x2*)(CINT + base) = w2;
                st = dec * st + d; }
            float* out = P.out + (type == 0 ? O_PC : O_PS) + (size_t)((j * 8 + b) * 4 + h) * 8192;
            const int dv = e >> 6, dk = e & 63;
#pragma unroll
            for (int jj = 0; jj < 4; ++jj) out[(dk + jj) * 128 + dv] = st[jj];
            if (type == 0 && q == 0 && tid < 64) { float ns = 0.f;
#pragma unroll 1
                for (int c0 = 0; c0 < 32; c0 += 8) { float wv[8], dv8[8];
#pragma unroll
                    for (int u = 0; u < 8; ++u) { const int i = seq * 32 + c0 + u; wv[u] = SCAL[i * 4 + 1]; dv8[u] = DN[(size_t)i * 64 + tid]; }
#pragma unroll
                    for (int u = 0; u < 8; ++u) { const int i = seq * 32 + c0 + u; NIN[(size_t)i * 64 + tid] = ns; ns = wv[u] * ns + dv8[u]; } }
                P.out[O_PN + (size_t)((j * 8 + b) * 4 + h) * 64 + tid] = ns; }
        } else {
            const int r = task - 256, type = r >> 9, bh = r & 511, b = bh >> 2, h = bh & 3, i = 1024 + bh;
            LAS float* T1 = (LAS float*)lds; LAS float* T2 = (LAS float*)(lds + 33280);
            const size_t base = (size_t)(type * NITEM + i) * 8192;
#pragma unroll
            for (int k = 0; k < 4; ++k) { const int e = tid * 4 + k * 2048; const f32x4 d = *(const f32x4*)(DCT + base + e); const int dv = e >> 6, dk = e & 63;
                T1[dv * 65 + dk] = d[0]; T1[dv * 65 + dk + 1] = d[1]; T1[dv * 65 + dk + 2] = d[2]; T1[dv * 65 + dk + 3] = d[3]; }
            const float* sin = (type == 0 ? P.in[2] : P.in[5]) + (size_t)((j * 128 + b) * 4 + h) * 8192;
            float* sout = P.out + (type == 0 ? O_SC : O_SS) + (size_t)((j * 128 + b) * 4 + h) * 8192;
            const float wl0 = SCAL[i * 4 + 1];
            f32x4 s0v[4]; float decv[4];
#pragma unroll
            for (int k = 0; k < 4; ++k) { const int e2 = tid * 4 + k * 2048; s0v[k] = *(const f32x4*)(sin + e2); decv[k] = type == 0 ? wl0 : DEC[(size_t)i * 64 + (e2 >> 7)]; }
            __syncthreads();
#pragma unroll
            for (int k = 0; k < 4; ++k) { const int e2 = tid * 4 + k * 2048; const int dk = e2 >> 7, dv = e2 & 127; const f32x4 s0 = s0v[k];
                const float dec = decv[k]; f32x4 nv;
#pragma unroll
                for (int jj = 0; jj < 4; ++jj) { nv[jj] = dec * s0[jj] + T1[(dv + jj) * 65 + dk]; T2[dk * 129 + dv + jj] = s0[jj]; }
                *(f32x4*)(sout + e2) = nv; }
            __syncthreads();
#pragma unroll
            for (int k = 0; k < 4; ++k) { const int e = tid * 4 + k * 2048; const int dv = e >> 6, dk = e & 63; u32x2 w2;
                w2.x = pk2(T2[dk * 129 + dv], T2[(dk + 1) * 129 + dv]); w2.y = pk2(T2[(dk + 2) * 129 + dv], T2[(dk + 3) * 129 + dv]); *(u32x2*)(CINT + base + e) = w2; }
            if (type == 0 && tid < 64) { const float n0 = P.in[3][(size_t)((j * 128 + b) * 4 + h) * 64 + tid]; NIN[(size_t)i * 64 + tid] = n0;
                P.out[O_SN + (size_t)((j * 128 + b) * 4 + h) * 64 + tid] = wl0 * n0 + DN[(size_t)i * 64 + tid]; }
            __syncthreads();
        }
    }
}

template <int TYPE> __device__ __forceinline__ void ab_out_item(const Params& P, LAS unsigned char* lds, int j, int i) {
    const int tid = otid(), lane = tid & 63, wave = __builtin_amdgcn_readfirstlane(tid >> 6);
    const AbItem it = ab_decode(i);
    const int h = it.h, m0 = it.m0, nvalid = it.nvalid;
    LAS bf16_t* Q = (LAS bf16_t*)lds; LAS bf16_t* Kx = (LAS bf16_t*)(lds + 9216); LAS bf16_t* VT = (LAS bf16_t*)(lds + 18432); LAS bf16_t* C0T = (LAS bf16_t*)(lds + 36864);
    LAS bf16_t* Sw = (LAS bf16_t*)(lds + 55296); LAS float* Ob = (LAS float*)(lds + 64512);
    LAS float* bt = (LAS float*)(lds + 98304); LAS float* igt = bt + 64; LAS float* mt = bt + 128; LAS float* wint = bt + 192; LAS float* rden = bt + 256; LAS float* n0L = bt + 320;
    LAS float* Ac = (LAS float*)(lds + 99840);
    const bf16_t* Pb = (const bf16_t*)(P.ws + WS_P);
    const float* GT = (const float*)(P.ws + WS_GT);
    const int qcol = TYPE == 0 ? h * 64 : 1536 + h * 64, kcol = TYPE == 0 ? 256 + h * 64 : 1792 + h * 64, vcol = TYPE == 0 ? 512 + h * 128 : 2048 + h * 128, gcol = TYPE == 0 ? 1024 + h * 128 : 2560 + h * 128;
    const int ls = tid >> 3, ld8 = (tid & 7) * 8, lv16 = (tid & 7) * 16;
    u32x4 qv = {0u, 0u, 0u, 0u}, kv = {0u, 0u, 0u, 0u}, va = {0u, 0u, 0u, 0u}, vb = {0u, 0u, 0u, 0u};
    if (ls < nvalid) { const bf16_t* rowp = Pb + (size_t)(m0 + ls) * ABN; qv = *(const u32x4*)(rowp + qcol + ld8); kv = *(const u32x4*)(rowp + kcol + ld8);
        }
    { const int vr = 2 * (tid >> 4), vc = (tid & 15) * 8;
      if (vr < nvalid) va = *(const u32x4*)(Pb + (size_t)(m0 + vr) * ABN + vcol + vc);
      if (vr + 1 < nvalid) vb = *(const u32x4*)(Pb + (size_t)(m0 + vr + 1) * ABN + vcol + vc); }
    const int crow = tid >> 3, csg = (tid & 7) * 8;
    const bf16_t* csrc = (const bf16_t*)(P.ws + WS_CINT) + (size_t)(TYPE * NITEM + i) * 8192 + crow * 64 + csg;
    const u32x4 c0a = *(const u32x4*)csrc, c0b = *(const u32x4*)(csrc + 64 * 64);
    const int nt_ = tid >> 3, nsg = tid & 7;
    u32x4 gpa = {0u, 0u, 0u, 0u}, gpb = {0u, 0u, 0u, 0u};
    if (nt_ < nvalid) { const bf16_t* gp = Pb + (size_t)(m0 + nt_) * ABN + gcol + nsg * 8; gpa = *(const u32x4*)gp; gpb = *(const u32x4*)(gp + 64); }
    const float* nrm = (TYPE == 0 ? P.in[11] : P.in[14]) + j * 512 + h * 128;
    float acv[8];
    if (TYPE == 0) {
        if (wave == 0) {
            const float igb = P.in[9][j * 4 + h], fgb = P.in[10][j * 4 + h];
            float lf = 0.f, ig = -INFINITY;
            if (lane < nvalid) { lf = logsig(GT[(size_t)(4 + h) * MT + m0 + lane] + fgb); ig = GT[(size_t)h * MT + m0 + lane] + igb; }
            const float mprev = ((const float*)(P.ws + WS_SCAL))[(size_t)i * 4];
            const float n0v = ((const float*)(P.ws + WS_NIN))[(size_t)i * 64 + lane];
            const float bs = wave_scan_add(lf, lane); const float am = wave_scan_max(ig - bs, lane);
            const float mtv = bs + fmaxf(mprev, am);
            bt[lane] = bs; igt[lane] = ig; mt[lane] = mtv; wint[lane] = __expf(bs + mprev - mtv); n0L[lane] = n0v;
        }
    } else {
        const float* acg = (const float*)(P.ws + WS_ACUM) + (size_t)i * 4096;
#pragma unroll
        for (int q = 0; q < 8; ++q) acv[q] = acg[tid + q * 512];
#pragma unroll
        for (int q = 0; q < 8; ++q) { const int idx = tid + q * 512; Ac[(idx >> 6) * 65 + (idx & 63)] = acv[q]; }
        __syncthreads();
    }
    { float qf[8], kf[8];
#pragma unroll
      for (int e = 0; e < 8; ++e) {
          if (TYPE == 0) { qf[e] = bfe(qv, e); kf[e] = bfe(kv, e) * 0.125f; }
          else { const float a = Ac[ls * 65 + ld8 + e]; qf[e] = bfe(qv, e) * 0.125f * __expf(a); kf[e] = bfe(kv, e) * __expf(-a); } }
      u32x4 qw, kw; qw.x = pk2(qf[0], qf[1]); qw.y = pk2(qf[2], qf[3]); qw.z = pk2(qf[4], qf[5]); qw.w = pk2(qf[6], qf[7]);
      kw.x = pk2(kf[0], kf[1]); kw.y = pk2(kf[2], kf[3]); kw.z = pk2(kf[4], kf[5]); kw.w = pk2(kf[6], kf[7]);
      *(LAS u32x4*)(Q + ls * 72 + ld8) = qw; *(LAS u32x4*)(Kx + ls * 72 + ld8) = kw; }
    write_vt(VT, va, vb, tid);
    *(LAS u32x4*)(C0T + crow * 72 + csg) = c0a; *(LAS u32x4*)(C0T + (64 + crow) * 72 + csg) = c0b;
    __syncthreads();
    { const int rt = wave >> 1, ct0 = (wave & 1) * 2;
      f32x4 sa[2] = {(f32x4){0.f, 0.f, 0.f, 0.f}, (f32x4){0.f, 0.f, 0.f, 0.f}};
#pragma unroll
      for (int ks = 0; ks < 2; ++ks) { const bf16x8 a = ldsfrag(Q, rt * 16, 72, ks * 32, lane);
#pragma unroll
          for (int jj = 0; jj < 2; ++jj) { const bf16x8 bb = ldsfrag(Kx, (ct0 + jj) * 16, 72, ks * 32, lane); sa[jj] = mma(a, bb, sa[jj]); } }
#pragma unroll
      for (int jj = 0; jj < 2; ++jj)
#pragma unroll
          for (int r = 0; r < 4; ++r) { const int t = rt * 16 + (lane >> 4) * 4 + r, s = (ct0 + jj) * 16 + (lane & 15); float v = 0.f;
              if (s <= t) { v = sa[jj][r]; if (TYPE == 0) v *= __expf(bt[t] - bt[s] + igt[s] - mt[t]); }
              Sw[t * 72 + s] = f2bf(v); } }
    __syncthreads();
    if (TYPE == 0 && tid < 64) {
        const int t = tid; float den = 0.f, qn = 0.f;
#pragma unroll
        for (int s = 0; s < 64; s += 8) { const u32x4 sv = *(const LAS u32x4*)(Sw + t * 72 + s), qq = *(const LAS u32x4*)(Q + t * 72 + s);
#pragma unroll
            for (int e = 0; e < 8; ++e) { den += bfe(sv, e); qn += bfe(qq, e) * n0L[s + e]; } }
        den += wint[t] * qn;
        rden[t] = 1.f / fmaxf(fabsf(den), __expf(-mt[t]));
    }
    { const int rt = wave >> 1, ct0 = (wave & 1) * 4;
      f32x4 o[4];
#pragma unroll
      for (int jj = 0; jj < 4; ++jj) o[jj] = (f32x4){0.f, 0.f, 0.f, 0.f};
#pragma unroll
      for (int ks = 0; ks < 2; ++ks) { const bf16x8 a = ldsfrag(Q, rt * 16, 72, ks * 32, lane);
#pragma unroll
          for (int jj = 0; jj < 4; ++jj) { const bf16x8 bb = ldsfrag(C0T, (ct0 + jj) * 16, 72, ks * 32, lane); o[jj] = mma(a, bb, o[jj]); } }
      if (TYPE == 0) {
#pragma unroll
          for (int r = 0; r < 4; ++r) { const float w = wint[rt * 16 + (lane >> 4) * 4 + r];
#pragma unroll
              for (int jj = 0; jj < 4; ++jj) o[jj][r] *= w; } }
#pragma unroll
      for (int ks = 0; ks < 2; ++ks) { const bf16x8 a = ldsfrag(Sw, rt * 16, 72, ks * 32, lane);
#pragma unroll
          for (int jj = 0; jj < 4; ++jj) { const bf16x8 bb = ldsfrag_swz(VT, (ct0 + jj) * 16, 72, ks * 32, lane); o[jj] = mma(a, bb, o[jj]); } }
#pragma unroll
      for (int jj = 0; jj < 4; ++jj)
#pragma unroll
          for (int r = 0; r < 4; ++r) Ob[(rt * 16 + (lane >> 4) * 4 + r) * 132 + (ct0 + jj) * 16 + (lane & 15)] = o[jj][r]; }
    __syncthreads();
    { bf16_t* MIXb = (bf16_t*)(P.ws + WS_MIX);
      const float rd = TYPE == 0 ? rden[nt_] : 1.f;
      float x[16]; float sm = 0.f;
#pragma unroll
      for (int q = 0; q < 4; ++q) { const f32x4 o4 = *(const LAS f32x4*)(Ob + nt_ * 132 + (q >> 1) * 64 + nsg * 8 + (q & 1) * 4);
#pragma unroll
          for (int e = 0; e < 4; ++e) { x[q * 4 + e] = o4[e] * rd; sm += x[q * 4 + e]; } }
      sm += __shfl_xor(sm, 1); sm += __shfl_xor(sm, 2); sm += __shfl_xor(sm, 4);
      const float mean = sm * (1.f / 128.f); float qv2 = 0.f;
#pragma unroll
      for (int e = 0; e < 16; ++e) { x[e] -= mean; qv2 += x[e] * x[e]; }
      qv2 += __shfl_xor(qv2, 1); qv2 += __shfl_xor(qv2, 2); qv2 += __shfl_xor(qv2, 4);
      const float rs = rsqrtf(qv2 * (1.f / 128.f) + LN_EPS);
      float o[16];
#pragma unroll
      for (int q = 0; q < 4; ++q) { const f32x4 gq = *(const f32x4*)(nrm + (q >> 1) * 64 + nsg * 8 + (q & 1) * 4);
#pragma unroll
          for (int e = 0; e < 4; ++e) { const int idx = q * 4 + e; const float p = idx < 8 ? bfe(gpa, idx & 7) : bfe(gpb, idx & 7);
              const float gate = TYPE == 0 ? sigm(p) : p * sigm(p); o[idx] = x[idx] * rs * gq[e] * gate; } }
      if (nt_ < nvalid) { u32x4 w0, w1;
          w0.x = pk2(o[0], o[1]); w0.y = pk2(o[2], o[3]); w0.z = pk2(o[4], o[5]); w0.w = pk2(o[6], o[7]);
          w1.x = pk2(o[8], o[9]); w1.y = pk2(o[10], o[11]); w1.z = pk2(o[12], o[13]); w1.w = pk2(o[14], o[15]);
          bf16_t* mp = MIXb + (size_t)(m0 + nt_) * 1024 + TYPE * 512 + h * 128 + nsg * 8;
          *(u32x4*)mp = w0; *(u32x4*)(mp + 64) = w1; } }
    __syncthreads();
}

__device__ __forceinline__ void ssd_conv_phase(const Params& P, int j) {
    const int gtid = blockIdx.x * 512 + otid(), gsz = gridDim.x * 512;
    const bf16_t* Pb = (const bf16_t*)(P.ws + WS_P); bf16_t* CONVB = (bf16_t*)(P.ws + WS_CONVB);
    const float* cw = P.in[17] + (size_t)j * 4 * 3072; const float* cb = P.in[18] + (size_t)j * 3072;
    for (int idx = gtid; idx < 1024 * 384; idx += gsz) {
        const int blk = idx / 384, c8 = idx - blk * 384, ch = c8 * 8, ms = blk * 16;
        float w[4][8], bias[8];
#pragma unroll
        for (int q = 0; q < 4; ++q) { const f32x4 a = *(const f32x4*)(cw + (size_t)q * 3072 + ch), b = *(const f32x4*)(cw + (size_t)q * 3072 + ch + 4);
            w[q][0] = a[0]; w[q][1] = a[1]; w[q][2] = a[2]; w[q][3] = a[3]; w[q][4] = b[0]; w[q][5] = b[1]; w[q][6] = b[2]; w[q][7] = b[3]; }
        { const f32x4 a = *(const f32x4*)(cb + ch), b = *(const f32x4*)(cb + ch + 4); bias[0] = a[0]; bias[1] = a[1]; bias[2] = a[2]; bias[3] = a[3]; bias[4] = b[0]; bias[5] = b[1]; bias[6] = b[2]; bias[7] = b[3]; }
        float f0[8], f1[8], f2[8];
#pragma unroll
        for (int e = 0; e < 8; ++e) { f0[e] = 0.f; f1[e] = 0.f; f2[e] = 0.f; }
        const bf16_t* src = Pb + (size_t)ms * SSDN + 2048 + ch;
        if ((ms & 2047) != 0) { const u32x4 q0 = *(const u32x4*)(src - 3 * SSDN), q1 = *(const u32x4*)(src - 2 * SSDN), q2 = *(const u32x4*)(src - SSDN);
#pragma unroll
            for (int e = 0; e < 8; ++e) { f0[e] = bfe(q0, e); f1[e] = bfe(q1, e); f2[e] = bfe(q2, e); } }
#pragma unroll 8
        for (int rr = 0; rr < 16; ++rr) {
            const u32x4 r3 = *(const u32x4*)(src + (size_t)rr * SSDN);
            float v[8];
#pragma unroll
            for (int e = 0; e < 8; ++e) { const float f3 = bfe(r3, e);
                const float a = fmaf(f3, w[3][e], fmaf(f2[e], w[2][e], fmaf(f1[e], w[1][e], fmaf(f0[e], w[0][e], bias[e]))));
                v[e] = a * sigm(a); f0[e] = f1[e]; f1[e] = f2[e]; f2[e] = f3; }
            u32x4 o; o.x = pk2(v[0], v[1]); o.y = pk2(v[2], v[3]); o.z = pk2(v[4], v[5]); o.w = pk2(v[6], v[7]);
            *(u32x4*)(CONVB + (size_t)(ms + rr) * 3072 + ch) = o;
        }
    }
    for (int idx = gtid; idx < MS * 384; idx += gsz) {
        const int ms = idx / 384, c8 = idx - ms * 384, ch = c8 * 8, b = ms >> 2, t = ms & 3;
        float v[8];
        { const f32x4 a = *(const f32x4*)(cb + ch), bb = *(const f32x4*)(cb + ch + 4); v[0] = a[0]; v[1] = a[1]; v[2] = a[2]; v[3] = a[3]; v[4] = bb[0]; v[5] = bb[1]; v[6] = bb[2]; v[7] = bb[3]; }
#pragma unroll
        for (int q = 0; q < 4; ++q) { const int tt = t - 3 + q; float raw[8];
            if (tt >= 0) { const u32x4 rv = *(const u32x4*)(Pb + (size_t)(MP + b * 4 + tt) * SSDN + 2048 + ch);
#pragma unroll
                for (int e = 0; e < 8; ++e) raw[e] = bfe(rv, e); }
            else { const float* cp = P.in[7] + ((size_t)(j * 128 + b) * 3 + (3 + tt)) * 3072 + ch; const f32x4 a = *(const f32x4*)cp, bb = *(const f32x4*)(cp + 4);
                raw[0] = a[0]; raw[1] = a[1]; raw[2] = a[2]; raw[3] = a[3]; raw[4] = bb[0]; raw[5] = bb[1]; raw[6] = bb[2]; raw[7] = bb[3]; }
            const f32x4 w0 = *(const f32x4*)(cw + (size_t)q * 3072 + ch), w1 = *(const f32x4*)(cw + (size_t)q * 3072 + ch + 4);
            v[0] += raw[0] * w0[0]; v[1] += raw[1] * w0[1]; v[2] += raw[2] * w0[2]; v[3] += raw[3] * w0[3];
            v[4] += raw[4] * w1[0]; v[5] += raw[5] * w1[1]; v[6] += raw[6] * w1[2]; v[7] += raw[7] * w1[3]; }
#pragma unroll
        for (int e = 0; e < 8; ++e) v[e] = v[e] * sigm(v[e]);
        u32x4 o; o.x = pk2(v[0], v[1]); o.y = pk2(v[2], v[3]); o.z = pk2(v[4], v[5]); o.w = pk2(v[6], v[7]);
        *(u32x4*)(CONVB + (size_t)(MP + ms) * 3072 + ch) = o;
    }
    { const float* GT = (const float*)(P.ws + WS_GT); float* DTB = (float*)(P.ws + WS_DTB); float* CS = (float*)(P.ws + WS_CS);
      const int lane = gtid & 63, gw = gtid >> 6, nw = gsz >> 6;
      for (int task = gw; task < 32 * (MT / 64); task += nw) { const int hd = task / (MT / 64), blk = task - hd * (MT / 64); const size_t idx = (size_t)hd * MT + blk * 64 + lane;
          const float dt = softplusf(GT[idx] + P.in[19][j * 32 + hd]); const float a = dt * -__expf(P.in[20][j * 32 + hd]); float cs;
          if (blk < MP / 64) cs = wave_scan_add(a, lane);
          else { const int pos = lane & 3; const float a1 = __shfl_up(a, 1), a2 = __shfl_up(a, 2), a3 = __shfl_up(a, 3); cs = a + (pos >= 1 ? a1 : 0.f) + (pos >= 2 ? a2 : 0.f) + (pos >= 3 ? a3 : 0.f); }
          DTB[idx] = dt; CS[idx] = cs; } }
}

struct SsdStep { int samp, b, head, m0, nvalid, last; };
__device__ __forceinline__ void ssd_decode(int item, int c, SsdStep& s) {
    if (item < 256) { s.samp = 0; s.b = item >> 5; s.head = item & 31; s.m0 = s.b * 2048 + c * 64; s.nvalid = 64; s.last = (c == 31); }
    else { const int r = item - 256; s.samp = 1; s.b = r >> 5; s.head = r & 31; s.m0 = MP + s.b * 4; s.nvalid = 4; s.last = 1; }
}
__device__ __forceinline__ void ssd_dma_issue(const SsdStep& s, const bf16_t* CONVB, const bf16_t* Pb, LAS unsigned char* lds, int tid, int wave) {
    const int g = s.head >> 3;
#pragma unroll
    for (int i = 0; i < 6; ++i) {
        const int q = i * 512 + tid; const int r = q / 48, cp = q - r * 48;
        const bf16_t* src;
        if (cp < 40) { const int col = cp < 8 ? s.head * 64 + cp * 8 : (cp < 24 ? 2048 + g * 128 + (cp - 8) * 8 : 2560 + g * 128 + (cp - 24) * 8); src = CONVB + (size_t)(s.m0 + r) * 3072 + col; }
        else src = Pb + (size_t)(s.m0 + r) * SSDN + s.head * 64 + (cp - 40) * 8;
        __builtin_amdgcn_global_load_lds((const unsigned*)src, (LAS unsigned*)(lds + i * 8192 + wave * 1024), 16, 0, 0);
    }
}

__device__ __forceinline__ void ssd_phase(const Params& P, LAS unsigned char* lds, int j) {
    const int tid = otid(), lane = tid & 63, wave = __builtin_amdgcn_readfirstlane(tid >> 6);
    constexpr int TILE_B = 64 * 41 * 16, TLD = 328;
    LAS bf16_t* XT = (LAS bf16_t*)(lds + 83968); LAS bf16_t* BwT = (LAS bf16_t*)(lds + 93184); LAS bf16_t* H0 = (LAS bf16_t*)(lds + 111616);
    LAS bf16_t* G = (LAS bf16_t*)(lds + 129024); LAS float* sc = (LAS float*)(lds + 138240);
    LAS float* Yb = (LAS float*)(lds + 139264);
    const bf16_t* Pb = (const bf16_t*)(P.ws + WS_P); const bf16_t* CONVB = (const bf16_t*)(P.ws + WS_CONVB);
    const float* DT = (const float*)(P.ws + WS_DTB);
    bf16_t* YG = (bf16_t*)(P.ws + WS_YG); float* SQ = (float*)(P.ws + WS_SQ);
    const int NIT = 256 + 4096;
    int item = blockIdx.x, c = 0;
    if (gridDim.x == 256) { const int x = item & 7, slot = item >> 3, pair = x * 4 + (slot >> 3); item = (pair >> 2) * 32 + (pair & 3) * 8 + (slot & 7); }
    if (item >= NIT) return;
    int eoff[6], hmul[6], gmul[6];
#pragma unroll
    for (int i = 0; i < 6; ++i) { int q = i * 512 + tid; if (q >= 64 * 41) q = 0; const int r = q / 41, cp = q - r * 41;
        if (cp < 8)       { eoff[i] = r * 3072 + cp * 8;                 hmul[i] = 64; gmul[i] = 0; }
        else if (cp < 24) { eoff[i] = r * 3072 + 2048 + (cp - 8) * 8;    hmul[i] = 0;  gmul[i] = 128; }
        else if (cp < 40) { eoff[i] = r * 3072 + 2560 + (cp - 24) * 8;   hmul[i] = 0;  gmul[i] = 128; }
        else              { eoff[i] = r * 3072;                          hmul[i] = 64; gmul[i] = 0; } }
#define SSD_DMA(st, buf) do { const int g_ = (st).head >> 3; LAS unsigned char* tb_ = lds + (buf) * TILE_B; _Pragma("unroll") for (int i = 0; i < 6; ++i) { if (i < 5 || wave == 0) { \
        const bf16_t* src_ = CONVB + (size_t)(st).m0 * 3072 + eoff[i] + (st).head * hmul[i] + g_ * gmul[i]; \
        __builtin_amdgcn_global_load_lds((const unsigned*)src_, (LAS unsigned*)(tb_ + i * 8192 + wave * 1024), 16, 0, 0); } } } while (0)
    const int zt = tid >> 3, zp8 = (tid & 7) * 8;
    SsdStep cur; ssd_decode(item, 0, cur);
    SSD_DMA(cur, 0);
    u32x4 znext = {0u, 0u, 0u, 0u};
    if (zt < cur.nvalid) znext = *(const u32x4*)(Pb + (size_t)(cur.m0 + zt) * SSDN + cur.head * 64 + zp8);
    const int pt = wave >> 1, nt0 = (wave & 1) * 4;
    const int hp = pt * 16 + (lane & 15), hn = (lane >> 4) * 4;
    f32x4 hst[4], hnx[4];
#pragma unroll
    for (int jj = 0; jj < 4; ++jj) { hst[jj] = (f32x4){0.f, 0.f, 0.f, 0.f}; hnx[jj] = (f32x4){0.f, 0.f, 0.f, 0.f}; }
    if (cur.samp) { const float* hin = P.in[6] + (size_t)((j * 128 + cur.b) * 32 + cur.head) * 8192;
#pragma unroll
        for (int jj = 0; jj < 4; ++jj) hnx[jj] = *(const f32x4*)(hin + hp * 128 + (nt0 + jj) * 16 + hn); }
    const float* CSB = (const float*)(P.ws + WS_CS);
    if (wave == 0) { float dt = 0.f; if (lane < cur.nvalid) dt = DT[(size_t)cur.head * MT + cur.m0 + lane];
        const float cs = CSB[(size_t)cur.head * MT + cur.m0 + min(lane, cur.nvalid - 1)]; sc[lane] = dt; sc[64 + lane] = cs; }
    int par = 0; float gtv = 0.f, gcs = 0.f;
    u32x4 zreg = {0u, 0u, 0u, 0u};
    u32x4 o_prev = {0u, 0u, 0u, 0u}; float sq_prev = 0.f; bf16_t* yp_prev = nullptr; float* sp_prev = nullptr; float* hp_prev = nullptr; f32x4 h_prev[4];
#pragma unroll
    for (int jj = 0; jj < 4; ++jj) h_prev[jj] = (f32x4){0.f, 0.f, 0.f, 0.f};
#define SSD_FLUSH() do { if (yp_prev) *(u32x4*)yp_prev = o_prev; if (sp_prev) *sp_prev = sq_prev; \
        if (hp_prev) { _Pragma("unroll") for (int jj = 0; jj < 4; ++jj) *(f32x4*)(hp_prev + (nt0 + jj) * 16) = h_prev[jj]; } yp_prev = nullptr; sp_prev = nullptr; hp_prev = nullptr; } while (0)
#pragma unroll 1
    for (;;) {
        const int nitem = cur.last ? item + (int)gridDim.x : item, nc = cur.last ? 0 : c + 1; const bool has_next = nitem < NIT;
        SsdStep nx = cur; if (has_next) ssd_decode(nitem, nc, nx);
        const float Dk = P.in[21][j * 32 + cur.head];
        LAS float* dts = sc + par * 128; LAS float* css = dts + 64;
        if (c == 0) {
#pragma unroll
            for (int jj = 0; jj < 4; ++jj) { hst[jj] = hnx[jj]; u32x2 w; w.x = pk2(hst[jj][0], hst[jj][1]); w.y = pk2(hst[jj][2], hst[jj][3]);
                *(LAS u32x2*)(H0 + hp * 136 + (nt0 + jj) * 16 + hn) = w; } }
        __builtin_amdgcn_s_waitcnt(0x0F70);
        RAW_BAR();
        const float csL = css[63];
        const int nvalid = cur.nvalid, m0 = cur.m0, head = cur.head;
        LAS bf16_t* tile = (LAS bf16_t*)(lds + par * TILE_B);
        const LAS bf16_t* CmP = tile + 192; const LAS bf16_t* BmP = tile + 64;
        zreg = znext;
        SSD_FLUSH();
        if (has_next) {
            if (wave == 0) { gtv = 0.f; if (lane < nx.nvalid) gtv = DT[(size_t)nx.head * MT + nx.m0 + lane]; gcs = CSB[(size_t)nx.head * MT + nx.m0 + min(lane, nx.nvalid - 1)]; }
            znext = (u32x4){0u, 0u, 0u, 0u};
            if (zt < nx.nvalid) znext = *(const u32x4*)(Pb + (size_t)(nx.m0 + zt) * SSDN + nx.head * 64 + zp8);
            if (cur.last) {
                if (nx.samp) { const float* hin = P.in[6] + (size_t)((j * 128 + nx.b) * 32 + nx.head) * 8192;
#pragma unroll
                    for (int jj = 0; jj < 4; ++jj) hnx[jj] = *(const f32x4*)(hin + hp * 128 + (nt0 + jj) * 16 + hn); }
                else {
#pragma unroll
                    for (int jj = 0; jj < 4; ++jj) hnx[jj] = (f32x4){0.f, 0.f, 0.f, 0.f}; } }
            SSD_DMA(nx, par ^ 1);
        }
        { const int rp = tid >> 4, c16 = tid & 15, r0 = 2 * rp, r1 = r0 + 1;
          u32x4 bv0 = {0u, 0u, 0u, 0u}, bv1 = bv0; float wl0 = 0.f, wl1 = 0.f;
          if (r0 < nvalid) { bv0 = *(const LAS u32x4*)(BmP + r0 * TLD + c16 * 8); wl0 = __expf(csL - css[r0]) * dts[r0]; }
          if (r1 < nvalid) { bv1 = *(const LAS u32x4*)(BmP + r1 * TLD + c16 * 8); wl1 = __expf(csL - css[r1]) * dts[r1]; }
#pragma unroll
          for (int e = 0; e < 8; ++e) *(LAS unsigned*)(BwT + (c16 * 8 + e) * 72 + (r0 ^ ((c16 & 7) << 3))) = pk2(bfe(bv0, e) * wl0, bfe(bv1, e) * wl1); }
        if (tid < 256) { const int rp = tid >> 3, c8 = tid & 7, r0 = 2 * rp, r1 = r0 + 1;
          u32x4 xv0 = {0u, 0u, 0u, 0u}, xv1 = xv0;
          if (r0 < nvalid) xv0 = *(const LAS u32x4*)(tile + r0 * TLD + c8 * 8);
          if (r1 < nvalid) xv1 = *(const LAS u32x4*)(tile + r1 * TLD + c8 * 8);
#pragma unroll
          for (int e = 0; e < 8; ++e) *(LAS unsigned*)(XT + (c8 * 8 + e) * 72 + (r0 ^ (c8 << 3))) = (unsigned)bfr(xv0, e) | ((unsigned)bfr(xv1, e) << 16); }
        { const int tt = wave >> 1, st0 = (wave & 1) * 2;
          f32x4 ca[2] = {(f32x4){0.f, 0.f, 0.f, 0.f}, (f32x4){0.f, 0.f, 0.f, 0.f}};
#pragma unroll
          for (int ks = 0; ks < 4; ++ks) { const bf16x8 bb = ldsfrag(CmP, tt * 16, TLD, ks * 32, lane);
#pragma unroll
              for (int jj = 0; jj < 2; ++jj) { const bf16x8 a = ldsfrag(BmP, (st0 + jj) * 16, TLD, ks * 32, lane); ca[jj] = mma(a, bb, ca[jj]); } }
          const int t = tt * 16 + (lane & 15); const float cst = css[t];
#pragma unroll
          for (int jj = 0; jj < 2; ++jj) { const int s0 = (st0 + jj) * 16 + (lane >> 4) * 4;
              const f32x4 cs4 = *(const LAS f32x4*)(css + s0), dt4 = *(const LAS f32x4*)(dts + s0); float v[4];
#pragma unroll
              for (int r = 0; r < 4; ++r) v[r] = (s0 + r <= t && s0 + r < nvalid) ? ca[jj][r] * __expf(cst - cs4[r]) * dt4[r] : 0.f;
              u32x2 w; w.x = pk2(v[0], v[1]); w.y = pk2(v[2], v[3]); *(LAS u32x2*)(G + t * 72 + s0) = w; } }
        RAW_BAR();
        { const int tt = wave >> 1, pp0 = (wave & 1) * 2;
          f32x4 y[2] = {(f32x4){0.f, 0.f, 0.f, 0.f}, (f32x4){0.f, 0.f, 0.f, 0.f}};
#pragma unroll
          for (int ks = 0; ks < 4; ++ks) { const bf16x8 bb = ldsfrag(CmP, tt * 16, TLD, ks * 32, lane);
#pragma unroll
              for (int jj = 0; jj < 2; ++jj) { const bf16x8 a = ldsfrag(H0, (pp0 + jj) * 16, 136, ks * 32, lane); y[jj] = mma(a, bb, y[jj]); } }
          const int t = tt * 16 + (lane & 15); const float ew = __expf(css[t]);
          y[0] = y[0] * ew; y[1] = y[1] * ew;
#pragma unroll
          for (int ks = 0; ks < 2; ++ks) { const bf16x8 bb = ldsfrag(G, tt * 16, 72, ks * 32, lane);
#pragma unroll
              for (int jj = 0; jj < 2; ++jj) { const bf16x8 a = ldsfrag_swz(XT, (pp0 + jj) * 16, 72, ks * 32, lane); y[jj] = mma(a, bb, y[jj]); } }
#pragma unroll
          for (int jj = 0; jj < 2; ++jj) { const int p0 = (pp0 + jj) * 16 + (lane >> 4) * 4;
              const u32x2 xw = *(const LAS u32x2*)(tile + t * TLD + p0);
              f32x4 o; o[0] = y[jj][0] + Dk * __uint_as_float(xw.x << 16); o[1] = y[jj][1] + Dk * __uint_as_float(xw.x & 0xffff0000u);
              o[2] = y[jj][2] + Dk * __uint_as_float(xw.y << 16); o[3] = y[jj][3] + Dk * __uint_as_float(xw.y & 0xffff0000u);
              *(LAS f32x4*)(Yb + t * 68 + p0) = o; } }
        { const float dec = __expf(csL);
#pragma unroll
          for (int jj = 0; jj < 4; ++jj) hst[jj] = hst[jj] * dec;
#pragma unroll
          for (int ks = 0; ks < 2; ++ks) { const bf16x8 bb = ldsfrag_swz(XT, pt * 16, 72, ks * 32, lane);
#pragma unroll
              for (int jj = 0; jj < 4; ++jj) { const bf16x8 a = ldsfrag_swz(BwT, (nt0 + jj) * 16, 72, ks * 32, lane); hst[jj] = mma(a, bb, hst[jj]); } } }
        RAW_BAR();
        { const int t = tid >> 3, p8 = (tid & 7) * 8;
          const f32x4 y0 = *(const LAS f32x4*)(Yb + t * 68 + p8), y1 = *(const LAS f32x4*)(Yb + t * 68 + p8 + 4);
          float yg[8]; float sq = 0.f;
#pragma unroll
          for (int e = 0; e < 8; ++e) { const float z = bfe(zreg, e); const float yv = (e < 4 ? y0[e & 3] : y1[e & 3]) * (z * sigm(z)); yg[e] = yv; sq += yv * yv; }
          sq += __shfl_xor(sq, 1); sq += __shfl_xor(sq, 2); sq += __shfl_xor(sq, 4);
          if (t < nvalid) { o_prev.x = pk2(yg[0], yg[1]); o_prev.y = pk2(yg[2], yg[3]); o_prev.z = pk2(yg[4], yg[5]); o_prev.w = pk2(yg[6], yg[7]);
              yp_prev = YG + (size_t)(m0 + t) * 2048 + head * 64 + p8;
              if ((tid & 7) == 0) { sq_prev = sq; sp_prev = SQ + (size_t)(m0 + t) * 32 + head; } } }
        if (cur.last) { float* hout = P.out + (cur.samp ? O_SH + (size_t)((j * 128 + cur.b) * 32 + head) * 8192 : O_PH + (size_t)((j * 8 + cur.b) * 32 + head) * 8192);
            hp_prev = hout + hp * 128 + hn;
#pragma unroll
            for (int jj = 0; jj < 4; ++jj) h_prev[jj] = hst[jj]; }
        else {
#pragma unroll
            for (int jj = 0; jj < 4; ++jj) { u32x2 w; w.x = pk2(hst[jj][0], hst[jj][1]); w.y = pk2(hst[jj][2], hst[jj][3]); *(LAS u32x2*)(H0 + hp * 136 + (nt0 + jj) * 16 + hn) = w; } }
        if (!has_next) break;
        if (wave == 0) { LAS float* nd = sc + (par ^ 1) * 128; nd[lane] = gtv; nd[64 + lane] = gcs; }
        cur = nx; item = nitem; c = nc; par ^= 1;
    }
    SSD_FLUSH();
#undef SSD_FLUSH
#undef SSD_DMA
    asm volatile("s_waitcnt vmcnt(0)" ::: "memory");
    __syncthreads();
}

__device__ __forceinline__ void ssd_norm_phase(const Params& P, int j) {
    const int gtid = blockIdx.x * 512 + otid(), gsz = gridDim.x * 512;
    const bf16_t* YG = (const bf16_t*)(P.ws + WS_YG); const float* SQ = (const float*)(P.ws + WS_SQ); bf16_t* MIXb = (bf16_t*)(P.ws + WS_MIX);
    const float* ng = P.in[22] + (size_t)j * 2048;
    for (int idx0 = gtid; idx0 < MT * 256; idx0 += 4 * gsz) {
        f32x4 s0[4], s1[4]; u32x4 yv[4];
#pragma unroll
        for (int q = 0; q < 4; ++q) { const int idx = idx0 + q * gsz; if (idx < MT * 256) { const int m = idx >> 8, c8 = idx & 255, g = c8 >> 6;
            s0[q] = *(const f32x4*)(SQ + (size_t)m * 32 + g * 8); s1[q] = *(const f32x4*)(SQ + (size_t)m * 32 + g * 8 + 4); yv[q] = *(const u32x4*)(YG + (size_t)m * 2048 + c8 * 8); } }
#pragma unroll
        for (int q = 0; q < 4; ++q) { const int idx = idx0 + q * gsz; if (idx < MT * 256) { const int m = idx >> 8, c8 = idx & 255;
            const float ss = ((s0[q][0] + s0[q][1]) + (s0[q][2] + s0[q][3])) + ((s1[q][0] + s1[q][1]) + (s1[q][2] + s1[q][3]));
            const float sc = rsqrtf(ss * (1.f / 512.f) + LN_EPS);
            const f32x4 g0 = *(const f32x4*)(ng + c8 * 8), g1 = *(const f32x4*)(ng + c8 * 8 + 4);
            u32x4 w; w.x = pk2(bfe(yv[q], 0) * sc * g0[0], bfe(yv[q], 1) * sc * g0[1]); w.y = pk2(bfe(yv[q], 2) * sc * g0[2], bfe(yv[q], 3) * sc * g0[3]);
            w.z = pk2(bfe(yv[q], 4) * sc * g1[0], bfe(yv[q], 5) * sc * g1[1]); w.w = pk2(bfe(yv[q], 6) * sc * g1[2], bfe(yv[q], 7) * sc * g1[3]);
            *(u32x4*)(MIXb + (size_t)m * 2048 + c8 * 8) = w; } }
    }
    const bf16_t* Pb = (const bf16_t*)(P.ws + WS_P);
    for (int idx = gtid; idx < (8 + 128) * 3 * 3072; idx += gsz) {
        const int ch = idx % 3072, rw = idx / 3072, w = rw % 3, bb = rw / 3;
        if (bb < 8) P.out[O_PCV + ((size_t)(j * 8 + bb) * 3 + w) * 3072 + ch] = bf2f(Pb[(size_t)(bb * 2048 + 2045 + w) * SSDN + 2048 + ch]);
        else { const int b = bb - 8; P.out[O_SCV + ((size_t)(j * 128 + b) * 3 + w) * 3072 + ch] = bf2f(Pb[(size_t)(MP + b * 4 + 1 + w) * SSDN + 2048 + ch]); }
    }
}

template <int EPI> __device__ __forceinline__ void small_gemm(LAS unsigned char* lds, const bf16_t* A, const bf16_t* Bt, int N, int K, bf16_t* O, const bf16_t* X, bf16_t* Y) {
    const int tid = otid(), lane = tid & 63, wave = __builtin_amdgcn_readfirstlane(tid >> 6);
    LAS float* red = (LAS float*)lds;
    LAS bf16_t* stg = (LAS bf16_t*)(lds + wave * 13824);
    const int ksl = K >> 3, nblk = ksl >> 6, nunits = 16 * (N >> 6);
    const int lr = lane >> 3, lc = (lane & 7) * 8;
    for (int u = blockIdx.x; u < nunits; u += gridDim.x) {
        const int rb = u & 15, cb = u >> 4;
        f32x4 acc[2][4];
#pragma unroll
        for (int m = 0; m < 2; ++m)
#pragma unroll
            for (int n = 0; n < 4; ++n) acc[m][n] = (f32x4){0.f, 0.f, 0.f, 0.f};
        const bf16_t* ap = A + (size_t)(rb * 32 + lr) * K + wave * ksl + lc;
        const bf16_t* bp = Bt + (size_t)(cb * 64 + lr) * K + wave * ksl + lc;
        u32x4 g[12];
#pragma unroll
        for (int i = 0; i < 4; ++i) g[i] = *(const u32x4*)(ap + (size_t)(i * 8) * K);
#pragma unroll
        for (int i = 0; i < 8; ++i) g[4 + i] = *(const u32x4*)(bp + (size_t)(i * 8) * K);
#pragma unroll 1
        for (int kb = 0; kb < nblk; ++kb) {
#pragma unroll
            for (int i = 0; i < 12; ++i) *(LAS u32x4*)(stg + (i * 8 + lr) * 72 + lc) = g[i];
            if (kb + 1 < nblk) {
#pragma unroll
                for (int i = 0; i < 4; ++i) g[i] = *(const u32x4*)(ap + (size_t)(i * 8) * K + (kb + 1) * 64);
#pragma unroll
                for (int i = 0; i < 8; ++i) g[4 + i] = *(const u32x4*)(bp + (size_t)(i * 8) * K + (kb + 1) * 64);
            }
#pragma unroll
            for (int q = 0; q < 2; ++q) { const bf16x8 a0 = ldsfrag(stg, 0, 72, q * 32, lane), a1 = ldsfrag(stg, 16, 72, q * 32, lane);
#pragma unroll
                for (int n = 0; n < 4; ++n) { const bf16x8 bq = ldsfrag(stg, 32 + n * 16, 72, q * 32, lane); acc[0][n] = mma(a0, bq, acc[0][n]); acc[1][n] = mma(a1, bq, acc[1][n]); } }
        }
        __syncthreads();
#pragma unroll
        for (int m = 0; m < 2; ++m)
#pragma unroll
            for (int n = 0; n < 4; ++n)
#pragma unroll
                for (int r = 0; r < 4; ++r) red[(wave * 32 + m * 16 + (lane >> 4) * 4 + r) * 68 + n * 16 + (lane & 15)] = acc[m][n][r];
        __syncthreads();
        { const int row = tid >> 4, c4 = (tid & 15) * 4;
          f32x4 s = *(const LAS f32x4*)(red + row * 68 + c4);
#pragma unroll
          for (int w = 1; w < 8; ++w) s = s + *(const LAS f32x4*)(red + (w * 32 + row) * 68 + c4);
          const int grow = rb * 32 + row, gcol = cb * 64 + c4;
          if (EPI == 2) { const u32x2 x = *(const u32x2*)(X + (size_t)grow * 1024 + gcol); u32x2 w2;
              w2.x = pk2(s[0] + DN_ALPHA * __uint_as_float(x.x << 16), s[1] + DN_ALPHA * __uint_as_float(x.x & 0xffff0000u));
              w2.y = pk2(s[2] + DN_ALPHA * __uint_as_float(x.y << 16), s[3] + DN_ALPHA * __uint_as_float(x.y & 0xffff0000u));
              *(u32x2*)(Y + (size_t)grow * 1024 + gcol) = w2; }
          else { if (EPI == 1) {
#pragma unroll
                  for (int q = 0; q < 4; ++q) { const float a = fmaxf(s[q], 0.f); s[q] = a * a; } }
              u32x2 w2; w2.x = pk2(s[0], s[1]); w2.y = pk2(s[2], s[3]); *(u32x2*)(O + (size_t)grow * N + gcol) = w2; } }
        __syncthreads();
    }
}

#ifndef REP_GEMM
#define REP_GEMM 1
#endif
#ifndef REP_P0
#define REP_P0 1
#endif
#ifndef REP_AB
#define REP_AB 1
#endif
#ifndef REP_S2
#define REP_S2 1
#endif
#ifndef REP_CONV
#define REP_CONV 1
#endif
#ifndef REP_BAR
#define REP_BAR 1
#endif
#ifndef REP_LN
#define REP_LN 1
#endif
#ifndef REP_SG
#define REP_SG 1
#endif
__global__ void __launch_bounds__(512) mega_fwd(Params P) {
    extern __shared__ __attribute__((aligned(16))) unsigned char smem[];
    LAS unsigned char* lds = (LAS unsigned char*)smem;
    const int tid = otid();
    volatile LAS unsigned* bst = (volatile LAS unsigned*)(lds + LDS_BAR_OFF);
    if (tid < 64) bst[tid] = 0u;
    __syncthreads();
    XcdBarrier bar = xcd_barrier_post((unsigned*)(P.ws + WS_CTL), bst);
    cg::grid_group grid = cg::this_grid();
#define GRID_BAR() do { for (int rb_ = 0; rb_ < REP_BAR; ++rb_) xcd_barrier(bar); } while (0)

#ifndef SKIP_P0
    for (int rep_ = 0; rep_ < REP_P0; ++rep_)
    p0_prologue(P, lds);
#endif
    if (P.ws == nullptr) grid.sync();
    GRID_BAR();

    const bf16_t* XB = (const bf16_t*)(P.ws + WS_XB); bf16_t* Y = (bf16_t*)(P.ws + WS_Y);
    bf16_t* Pb = (bf16_t*)(P.ws + WS_P); bf16_t* MIXb = (bf16_t*)(P.ws + WS_MIX); float* GT = (float*)(P.ws + WS_GT);
#pragma unroll 1
    for (int l = 0; l < 4; ++l) {
        const int j = l >> 1, ssd = l & 1;
        { const bf16_t* Bt = ssd ? (const bf16_t*)(P.ws + WS_WSSDIN) + (size_t)j * SSDN * 1024 : (const bf16_t*)(P.ws + WS_WABIN) + (size_t)j * ABN * 1024;
          const int N = ssd ? SSDN : ABN;
          pg8::Gemm g{XB, Bt, MP, N, 1024}; pg8::StaticOrder S; S.init(MP, N, gridDim.x, blockIdx.x);
          pg8::EpiB<0> E{Pb, N};
#ifndef SKIP_G1
          for (int rep_ = 0; rep_ < REP_GEMM; ++rep_)
          pg8::gemm_phase<pg8::EpiB<0>, pg8::StaticOrder>(lds, g, S, E, nullptr);
#endif
#ifndef SKIP_GATES
          for (int rep_ = 0; rep_ < REP_SG; ++rep_)
          small_gemm<0>(lds, XB + (size_t)MP * 1024, Bt, N, 1024, Pb + (size_t)MP * N, nullptr, nullptr);
          gates_phase(lds, XB, ssd ? (const bf16_t*)(P.ws + WS_WSSDG) + (size_t)j * 32768 : (const bf16_t*)(P.ws + WS_WABG) + (size_t)j * 32768, GT);
#endif
 }
        GRID_BAR();
        if (!ssd) {
#ifndef SKIP_A2
            for (int rep_ = 0; rep_ < REP_AB; ++rep_)
            for (int w = blockIdx.x; w < 2 * NITEM; w += gridDim.x) { if (w < NITEM) ab_delta_item<0>(P, lds, j, w); else ab_delta_item<1>(P, lds, j, w - NITEM); }
#endif
            GRID_BAR();
#ifndef SKIP_A3
            for (int rep_ = 0; rep_ < REP_AB; ++rep_)
            ab_scan_phase(P, lds, j);
#endif
            GRID_BAR();
#ifndef SKIP_A4
            for (int rep_ = 0; rep_ < REP_AB; ++rep_)
            for (int w = blockIdx.x; w < 2 * NITEM; w += gridDim.x) { if (w < NITEM) ab_out_item<0>(P, lds, j, w); else ab_out_item<1>(P, lds, j, w - NITEM); }
#endif
            GRID_BAR();
        } else {
            for (int rep_ = 0; rep_ < REP_CONV; ++rep_)
            ssd_conv_phase(P, j);
            GRID_BAR();
#ifndef SKIP_S2
            for (int rep_ = 0; rep_ < REP_S2; ++rep_)
            ssd_phase(P, lds, j);
#endif
            GRID_BAR();
#ifndef SKIP_S3
            for (int rep_ = 0; rep_ < REP_CONV; ++rep_)
            ssd_norm_phase(P, j);
#endif
            GRID_BAR();
        }
        { const bf16_t* Bt = ssd ? (const bf16_t*)(P.ws + WS_WSSDOUT) + (size_t)j * 1024 * 2048 : (const bf16_t*)(P.ws + WS_WABOUT) + (size_t)j * 1024 * 1024;
          const int K = ssd ? 2048 : 1024;
          pg8::Gemm g{MIXb, Bt, MP, 1024, K}; pg8::StaticOrder S; S.init(MP, 1024, gridDim.x, blockIdx.x);
          pg8::EpiRes E{XB, Y, 1024, DN_ALPHA};
#ifndef SKIP_G2
          for (int rep_ = 0; rep_ < REP_GEMM; ++rep_)
          pg8::gemm_phase<pg8::EpiRes, pg8::StaticOrder>(lds, g, S, E, nullptr);
#endif
          for (int rep_ = 0; rep_ < REP_SG; ++rep_)
          small_gemm<2>(lds, MIXb + (size_t)MP * K, Bt, 1024, K, nullptr, XB + (size_t)MP * 1024, Y + (size_t)MP * 1024);
 }
        GRID_BAR();
        for (int rep_ = 0; rep_ < REP_LN; ++rep_)
        ln_phase(Y, P.in[26] + (size_t)l * 1024, P.in[27] + (size_t)l * 1024, nullptr, (bf16_t*)(P.ws + WS_XB));
        GRID_BAR();
        { pg8::Gemm g{XB, (const bf16_t*)(P.ws + WS_W1) + (size_t)l * 4096 * 1024, MP, DFF, 1024}; pg8::StaticOrder S; S.init(MP, DFF, gridDim.x, blockIdx.x);
          pg8::EpiB<1> E{Pb, DFF};
#ifndef SKIP_G3
          for (int rep_ = 0; rep_ < REP_GEMM; ++rep_)
          pg8::gemm_phase<pg8::EpiB<1>, pg8::StaticOrder>(lds, g, S, E, nullptr);
#endif
          for (int rep_ = 0; rep_ < REP_SG; ++rep_)
          small_gemm<1>(lds, XB + (size_t)MP * 1024, g.Bt, DFF, 1024, Pb + (size_t)MP * DFF, nullptr, nullptr);
 }
        GRID_BAR();
        { pg8::Gemm g{Pb, (const bf16_t*)(P.ws + WS_W2) + (size_t)l * 1024 * 4096, MP, 1024, DFF}; pg8::StaticOrder S; S.init(MP, 1024, gridDim.x, blockIdx.x);
          pg8::EpiRes E{XB, Y, 1024, DN_ALPHA};
#ifndef SKIP_G4
          for (int rep_ = 0; rep_ < REP_GEMM; ++rep_)
          pg8::gemm_phase<pg8::EpiRes, pg8::StaticOrder>(lds, g, S, E, nullptr);
#endif
          for (int rep_ = 0; rep_ < REP_SG; ++rep_)
          small_gemm<2>(lds, Pb + (size_t)MP * DFF, g.Bt, 1024, DFF, nullptr, XB + (size_t)MP * 1024, Y + (size_t)MP * 1024);
 }
        GRID_BAR();
        for (int rep_ = 0; rep_ < REP_LN; ++rep_)
        ln_phase(Y, P.in[28] + (size_t)l * 1024, P.in[29] + (size_t)l * 1024, l == 3 ? P.out : nullptr, (bf16_t*)(P.ws + WS_XB));
        if (l < 3) GRID_BAR();
    }
}

extern "C" void kernel_launch(void* const* d_in, const int* in_sizes, int n_in, void* d_out, int out_size, void* d_ws, size_t ws_size, hipStream_t stream) {
    static int grid = 0;
    if (grid == 0) {
        if (n_in != 30 || (size_t)out_size != O_END || ws_size < WS_END) { fprintf(stderr, "kernel_launch: unexpected shapes (n_in %d, out %d, ws %zu)\n", n_in, out_size, ws_size); grid = -1; return; }
        int dev = 0, cus = 0, per_cu = 0;
        (void)hipGetDevice(&dev); (void)hipDeviceGetAttribute(&cus, hipDeviceAttributeMultiprocessorCount, dev);
        (void)hipFuncSetAttribute((const void*)mega_fwd, hipFuncAttributeMaxDynamicSharedMemorySize, LDS_BYTES);
        (void)hipOccupancyMaxActiveBlocksPerMultiprocessor(&per_cu, (const void*)mega_fwd, 512, LDS_BYTES);
        if (per_cu < 1) { fprintf(stderr, "kernel_launch: occupancy query says %d blocks per CU\n", per_cu); per_cu = 1; }
        grid = cus * per_cu; if (grid > 256) grid = 256;
        (void)hipGetLastError();
    }
    if (grid < 0) return;
    (void)hipMemsetAsync((char*)d_ws + WS_CTL, 0, CTL_BYTES, stream);
    Params p{};
    for (int i = 0; i < 30; ++i) p.in[i] = (const float*)d_in[i];
    p.out = (float*)d_out; p.ws = (unsigned char*)d_ws;
    void* args[] = {&p};
    hipError_t e = hipLaunchCooperativeKernel((const void*)mega_fwd, dim3(grid), dim3(512), args, LDS_BYTES, stream);
    if (e != hipSuccess) fprintf(stderr, "kernel_launch: cooperative launch failed: %s (grid %d)\n", hipGetErrorString(e), grid);
}
```

```cpp
#include <hip/hip_runtime.h>
#include <hip/hip_cooperative_groups.h>
#include <cstdio>
namespace cg = cooperative_groups;

namespace pg8 {
#define PG8_LAS __attribute__((address_space(3)))
typedef unsigned short bf16_t;
typedef short bf16x8 __attribute__((ext_vector_type(8)));
typedef float f32x4 __attribute__((ext_vector_type(4)));
typedef unsigned u32x4 __attribute__((ext_vector_type(4)));
constexpr int BM = 256, BK = 64, HALF = 128, HTB = HALF * BK * 2  , STAGE_BYTES = 8 * HTB, NXCD = 8, WGM = 8;

__host__ __device__ __forceinline__ int lds_byte(int r, int c) { const int st = (r >> 4) * 2 + (c >> 5), rr = r & 15, cc = c & 31, ob = rr * 64 + cc * 2; return st * 1024 + (ob ^ (((ob >> 9) & 1) << 5)); }
__host__ __device__ __forceinline__ void stage_rc(int b, int& R, int& C) { const int st = b / 1024, sb = b % 1024, swz = sb ^ (((sb >> 9) & 1) << 5); R = (st >> 1) * 16 + swz / 64; C = (st & 1) * 32 + (swz % 64) / 2; }
__host__ __device__ __forceinline__ int perm32(int rho) { const int n = rho >> 4, i = rho & 15; return 8 * (i >> 2) + 4 * n + (i & 3); }

struct Unit { int pm, pn; };
struct Gemm { const bf16_t* A; const bf16_t* Bt; int M, N, K; };

struct StaticOrder {
    int nM, nN, nwg, G, c;
    __host__ __device__ void init(int M, int N, int G_, int c_) { nM = M / BM; nN = N / BM; nwg = nM * nN; G = G_; c = c_; }
    __host__ __device__ bool next(int i, Unit& u) const {
        const long L = (long)i * G + c; if (L >= nwg) return false;
        int wgid = (int)L; { const int q = nwg / NXCD, r = nwg % NXCD, xcd = wgid % NXCD, off = wgid / NXCD; wgid = (xcd < r ? xcd * (q + 1) : r * (q + 1) + (xcd - r) * q) + off; }
        const int nig = WGM * nN, gid = wgid / nig, fm = gid * WGM, gsz = (nM - fm) < WGM ? (nM - fm) : WGM;
        u.pm = fm + ((wgid % nig) % gsz); u.pn = (wgid % nig) / gsz; return true;
    }
    __device__ __forceinline__ void a_ready(const Unit&) const {}
    __device__ __forceinline__ void done(const Unit&) const {}
};
__device__ __forceinline__ unsigned cvt_pk_bf16(float lo, float hi) { unsigned r; asm volatile("v_cvt_pk_bf16_f32 %0, %1, %2" : "=v"(r) : "v"(lo), "v"(hi)); return r; }

template <int ACT  > struct EpiB {
    static constexpr bool PERM = true, AFTER_DRAIN = false;
    bf16_t* O; int ldc;
    __device__ __forceinline__ void operator()(const f32x4 (&acc)[2][2][4][2], const Unit& u, int wr, int wc, int fr, int fq) const {
        const int row0 = u.pm * BM + wr * 64 + fr, col0 = u.pn * BM + wc * 32 + 8 * fq;
#pragma unroll
        for (int ai = 0; ai < 2; ++ai)
#pragma unroll
            for (int m = 0; m < 4; ++m) { bf16_t* rowp = O + (size_t)(row0 + ai * HALF + m * 16) * ldc + col0;
#pragma unroll
                for (int bj = 0; bj < 2; ++bj) { f32x4 v0 = acc[ai][bj][m][0], v1 = acc[ai][bj][m][1];
                    if (ACT == 1) {
#pragma unroll
                        for (int q = 0; q < 4; ++q) { const float a = fmaxf(v0[q], 0.f), b = fmaxf(v1[q], 0.f); v0[q] = a * a; v1[q] = b * b; } }
                    u32x4 w; w.x = cvt_pk_bf16(v0[0], v0[1]); w.y = cvt_pk_bf16(v0[2], v0[3]); w.z = cvt_pk_bf16(v1[0], v1[1]); w.w = cvt_pk_bf16(v1[2], v1[3]);
                    *(u32x4*)(rowp + bj * HALF) = w; } }
    }
};
struct EpiRes {
    static constexpr bool PERM = true, AFTER_DRAIN = false;
    const bf16_t* X; bf16_t* Y; int ldc; float alpha;
    __device__ __forceinline__ void operator()(const f32x4 (&acc)[2][2][4][2], const Unit& u, int wr, int wc, int fr, int fq) const {
        const int row0 = u.pm * BM + wr * 64 + fr, col0 = u.pn * BM + wc * 32 + 8 * fq;
#pragma unroll
        for (int ai = 0; ai < 2; ++ai)
#pragma unroll
            for (int m = 0; m < 4; ++m) { const size_t off = (size_t)(row0 + ai * HALF + m * 16) * ldc + col0;
#pragma unroll
                for (int bj = 0; bj < 2; ++bj) { const u32x4 x = *(const u32x4*)(X + off + bj * HALF); const f32x4 v0 = acc[ai][bj][m][0], v1 = acc[ai][bj][m][1];
                    u32x4 w;
                    w.x = cvt_pk_bf16(v0[0] + alpha * __uint_as_float(x.x << 16), v0[1] + alpha * __uint_as_float(x.x & 0xffff0000u));
                    w.y = cvt_pk_bf16(v0[2] + alpha * __uint_as_float(x.y << 16), v0[3] + alpha * __uint_as_float(x.y & 0xffff0000u));
                    w.z = cvt_pk_bf16(v1[0] + alpha * __uint_as_float(x.z << 16), v1[1] + alpha * __uint_as_float(x.z & 0xffff0000u));
                    w.w = cvt_pk_bf16(v1[2] + alpha * __uint_as_float(x.w << 16), v1[3] + alpha * __uint_as_float(x.w & 0xffff0000u));
                    *(u32x4*)(Y + off + bj * HALF) = w; }
                asm volatile("" ::: "memory"); }
    }
};

template <class Epi, class Sched, bool STAMP = false>
__device__ __forceinline__ void gemm_phase(PG8_LAS unsigned char* lds, const Gemm g, const Sched& S, const Epi& E, unsigned long long* stamps) {
    int tid_o = threadIdx.x; asm volatile("" : "+v"(tid_o)); const int tid = tid_o, wid = __builtin_amdgcn_readfirstlane(tid >> 6), lane = tid & 63, wr = wid >> 2, wc = wid & 3, fr = lane & 15, fq = lane >> 4;
    const int K = g.K, nt = K / BK;
    int ts_lo = 0, ts_hi = 0, nts = 0; const unsigned long long rt_entry = STAMP ? (unsigned long long)wall_clock64() : 0ull;
#define PG8_STAMP() do { if (STAMP && wid == 0 && nts < 64) { const unsigned long long _c = (unsigned long long)clock64(); \
        ts_lo = (lane == nts) ? (int)(unsigned)_c : ts_lo; ts_hi = (lane == nts) ? (int)(unsigned)(_c >> 32) : ts_hi; ++nts; } } while (0)
    PG8_STAMP();
    unsigned voffA[2], voffB[2];
#pragma unroll
    for (int i = 0; i < 2; ++i) { int R, C; stage_rc(tid * 16 + i * 8192, R, C); const int Rb = Epi::PERM ? ((R & ~31) + perm32(R & 31)) : R;
        voffA[i] = (unsigned)(R * K + C) * 2u; voffB[i] = (unsigned)(Rb * K + C) * 2u; }
    const size_t kstep = (size_t)(BK * 2);
    const size_t hstep = (size_t)HALF * K * 2;
    const size_t tstep = 2 * hstep;
    const unsigned ldsw = (unsigned)wid * 1024u;
    const int aoff = lds_byte(wr * 64 + fr, fq * 8), boff = lds_byte(wc * 32 + fr, fq * 8);
#define PG8_SA(b, h) (((b) * 2 + (h)) * HTB)
#define PG8_SB(b, h) ((4 + (b) * 2 + (h)) * HTB)
#define PG8_STAGE(bufoff, gbase, voff) do { _Pragma("unroll") for (int _i = 0; _i < 2; ++_i) \
        __builtin_amdgcn_global_load_lds((const unsigned*)((const char*)(gbase) + (voff)[_i]), (PG8_LAS unsigned*)(lds + (bufoff) + ldsw + _i * 8192), 16, 0, 0); } while (0)
#define PG8_LDA(dst, b, h) do { _Pragma("unroll") for (int m = 0; m < 4; ++m) _Pragma("unroll") for (int k = 0; k < 2; ++k) dst[m][k] = *(const PG8_LAS bf16x8*)(lds + PG8_SA(b, h) + aoff + m * 2048 + k * 1024); } while (0)
#define PG8_LDB(dst, b, h) do { _Pragma("unroll") for (int n = 0; n < 2; ++n) _Pragma("unroll") for (int k = 0; k < 2; ++k) dst[n][k] = *(const PG8_LAS bf16x8*)(lds + PG8_SB(b, h) + boff + n * 2048 + k * 1024); } while (0)
#define PG8_MMA(ai, bj, At, Bt) do { __builtin_amdgcn_s_setprio(1); _Pragma("unroll") for (int m = 0; m < 4; ++m) _Pragma("unroll") for (int n = 0; n < 2; ++n) _Pragma("unroll") for (int k = 0; k < 2; ++k) \
        acc[ai][bj][m][n] = __builtin_amdgcn_mfma_f32_16x16x32_bf16(Bt[n][k], At[m][k], acc[ai][bj][m][n], 0, 0, 0); __builtin_amdgcn_s_setprio(0); } while (0)
#define PG8_WAIT_V(n) asm volatile("s_waitcnt vmcnt(" #n ")" ::: "memory")
#define PG8_WAIT_L(n) asm volatile("s_waitcnt lgkmcnt(" #n ")" ::: "memory")
#define PG8_BAR __builtin_amdgcn_s_barrier()
#define PG8_SCHED __builtin_amdgcn_sched_barrier(0)
    Unit cur, nxt; int ui = 0;
    if (!S.next(0, cur)) return;
    f32x4 acc[2][2][4][2];
#pragma unroll
    for (int a = 0; a < 2; ++a)
#pragma unroll
        for (int b = 0; b < 2; ++b)
#pragma unroll
            for (int m = 0; m < 4; ++m)
#pragma unroll
                for (int n = 0; n < 2; ++n) acc[a][b][m][n] = (f32x4){0.f, 0.f, 0.f, 0.f};
    bf16x8 At[4][2], B0[2][2], B1[2][2];
    const char* cA = (const char*)g.A + (size_t)cur.pm * tstep; const char* cB = (const char*)g.Bt + (size_t)cur.pn * tstep;
    S.a_ready(cur);
    PG8_STAGE(PG8_SB(0, 0), cB, voffB); PG8_STAGE(PG8_SA(0, 0), cA, voffA); PG8_STAGE(PG8_SB(0, 1), cB + hstep, voffB); PG8_STAGE(PG8_SA(0, 1), cA + hstep, voffA);
    if (wr == 1) PG8_BAR;
    PG8_WAIT_V(4); PG8_BAR;
    PG8_STAGE(PG8_SB(1, 0), cB + kstep, voffB); PG8_STAGE(PG8_SA(1, 0), cA + kstep, voffA); PG8_STAGE(PG8_SB(1, 1), cB + hstep + kstep, voffB);
    PG8_WAIT_V(6); PG8_BAR;
    PG8_STAMP();
    for (;;) {
        const bool has_next = S.next(ui + 1, nxt);
        const char* nA = has_next ? (const char*)g.A + (size_t)nxt.pm * tstep : cA; const char* nB = has_next ? (const char*)g.Bt + (size_t)nxt.pn * tstep : cB;
        for (int t = 0; t < nt; t += 2) {
            const bool last = (t == nt - 2);
            const char* a1 = cA + (size_t)(t + 1) * kstep;
            const char* a2 = last ? nA : cA + (size_t)(t + 2) * kstep; const char* b2 = last ? nB : cB + (size_t)(t + 2) * kstep;
            const char* a3 = a2 + kstep; const char* b3 = b2 + kstep;
            if (last && has_next) S.a_ready(nxt);
            PG8_LDB(B0, 0, 0); PG8_SCHED; PG8_LDA(At, 0, 0); PG8_STAGE(PG8_SA(1, 1), a1 + hstep, voffA);
            PG8_WAIT_L(8); PG8_BAR; PG8_WAIT_L(0); PG8_MMA(0, 0, At, B0); PG8_BAR; PG8_SCHED;
            PG8_LDB(B1, 0, 1); PG8_STAGE(PG8_SB(0, 0), b2, voffB);
            PG8_BAR; PG8_WAIT_L(0); PG8_MMA(0, 1, At, B1); PG8_BAR;
            PG8_LDA(At, 0, 1); PG8_STAGE(PG8_SA(0, 0), a2, voffA);
            PG8_BAR; PG8_WAIT_L(0); PG8_MMA(1, 0, At, B0); PG8_BAR; PG8_SCHED;
            PG8_STAGE(PG8_SB(0, 1), b2 + hstep, voffB);
            PG8_WAIT_V(6); PG8_BAR; PG8_MMA(1, 1, At, B1); PG8_BAR;
            PG8_LDB(B0, 1, 0); PG8_SCHED; PG8_LDA(At, 1, 0); PG8_STAGE(PG8_SA(0, 1), a2 + hstep, voffA);
            PG8_WAIT_L(8); PG8_BAR; PG8_WAIT_L(0); PG8_MMA(0, 0, At, B0); PG8_BAR; PG8_SCHED;
            PG8_LDB(B1, 1, 1); PG8_STAGE(PG8_SB(1, 0), b3, voffB);
            PG8_BAR; PG8_WAIT_L(0); PG8_MMA(0, 1, At, B1); PG8_BAR;
            PG8_LDA(At, 1, 1); PG8_STAGE(PG8_SA(1, 0), a3, voffA);
            PG8_BAR; PG8_WAIT_L(0); PG8_MMA(1, 0, At, B0); PG8_BAR; PG8_SCHED;
            PG8_STAGE(PG8_SB(1, 1), b3 + hstep, voffB);
            PG8_WAIT_V(6); PG8_BAR; PG8_MMA(1, 1, At, B1); PG8_BAR;
        }
        PG8_STAMP();
        if constexpr (!Epi::AFTER_DRAIN) { E(acc, cur, wr, wc, fr, fq); S.done(cur); }
        PG8_STAMP();
        if (!has_next) break;
#pragma unroll
        for (int a = 0; a < 2; ++a)
#pragma unroll
            for (int b = 0; b < 2; ++b)
#pragma unroll
                for (int m = 0; m < 4; ++m)
#pragma unroll
                    for (int n = 0; n < 2; ++n) acc[a][b][m][n] = (f32x4){0.f, 0.f, 0.f, 0.f};
        cur = nxt; cA = nA; cB = nB; ++ui;
    }
    PG8_WAIT_V(0);
    if (wr == 0) PG8_BAR;
    PG8_BAR;
    if constexpr (Epi::AFTER_DRAIN) { E.fused(acc, cur, wr, wc, fr, fq, lds, wid, lane); S.done(cur); }
    PG8_STAMP();
    if (STAMP && wid == 0) { stamps[lane] = lane < nts ? (((unsigned long long)(unsigned)ts_hi << 32) | (unsigned)ts_lo) : 0ull;
        if (lane == 62) stamps[62] = rt_entry; if (lane == 63) stamps[63] = (unsigned long long)wall_clock64(); }
#undef PG8_STAMP
#undef PG8_SA
#undef PG8_SB
#undef PG8_STAGE
#undef PG8_LDA
#undef PG8_LDB
#undef PG8_MMA
#undef PG8_WAIT_V
#undef PG8_WAIT_L
#undef PG8_BAR
#undef PG8_SCHED
}
}

#define LAS __attribute__((address_space(3)))
typedef unsigned short bf16_t;
typedef short bf16x8 __attribute__((ext_vector_type(8)));
typedef float f32x4 __attribute__((ext_vector_type(4)));
typedef unsigned u32x4 __attribute__((ext_vector_type(4)));
typedef unsigned u32x2 __attribute__((ext_vector_type(2)));

constexpr int MP = 16384, MS = 512, MT = MP + MS;
constexpr int DM = 1024, DFF = 4096;
constexpr int ABN = 3072, ABSRC = 3096, SSDN = 5120, SSDSRC = 5152;
constexpr int NITEM = 1536;
constexpr float LN_EPS = 1e-5f;
constexpr float DN_ALPHA = 1.6817928305074290861f;

constexpr size_t MiB = (size_t)1 << 20;
constexpr size_t WS_CTL = 0, CTL_BYTES = 16384;
constexpr size_t WS_WABIN = 1 * MiB, WS_WABG = 13 * MiB, WS_WABOUT = 14 * MiB, WS_WSSDIN = 18 * MiB, WS_WSSDG = 38 * MiB, WS_WSSDOUT = 39 * MiB;
constexpr size_t WS_W1 = 47 * MiB, WS_W2 = 79 * MiB;
constexpr size_t WS_XF = 112 * MiB, WS_XB = 178 * MiB, WS_Y = 211 * MiB, WS_P = 277 * MiB  , WS_MIX = 442 * MiB, WS_YG = 508 * MiB;
constexpr size_t WS_GT = 574 * MiB, WS_SQ = 577 * MiB, WS_DCT = 580 * MiB, WS_CINT = 676 * MiB, WS_ACUM = 724 * MiB, WS_DN = 748 * MiB, WS_NIN = 749 * MiB, WS_DEC = 750 * MiB, WS_SCAL = 751 * MiB;
constexpr size_t WS_CONVB = WS_DCT;
constexpr size_t WS_CS = 752 * MiB;
constexpr size_t WS_DTB = 756 * MiB;
constexpr size_t WS_END = 760 * MiB;

constexpr size_t O_YP = 0, O_YS = 16777216, O_PC = O_YS + 524288, O_PN = O_PC + 524288, O_PM = O_PN + 4096, O_PS = O_PM + 64, O_PH = O_PS + 524288, O_PCV = O_PH + 4194304;
constexpr size_t O_SC = O_PCV + 147456, O_SN = O_SC + 8388608, O_SM = O_SN + 65536, O_SS = O_SM + 1024, O_SH = O_SS + 8388608, O_SCV = O_SH + 67108864, O_END = O_SCV + 2359296;

constexpr int LDS_BAR_OFF = 156672, LDS_BYTES = 156672 + 256;

struct Params { const float* in[30]; float* out; unsigned char* ws; };

#define RAW_BAR() do { asm volatile("s_waitcnt lgkmcnt(0)" ::: "memory"); __builtin_amdgcn_s_barrier(); asm volatile("" ::: "memory"); } while (0)
__device__ __forceinline__ int otid() { int t = threadIdx.x; asm volatile("" : "+v"(t)); return t; }
__device__ __forceinline__ float bf2f(bf16_t v) { return __uint_as_float(((unsigned)v) << 16); }
__device__ __forceinline__ unsigned pk2(float lo, float hi) { unsigned r; asm("v_cvt_pk_bf16_f32 %0, %1, %2" : "=v"(r) : "v"(lo), "v"(hi)); return r; }
__device__ __forceinline__ bf16_t f2bf(float f) { return (bf16_t)(pk2(f, f) & 0xffffu); }
__device__ __forceinline__ float bfe(const u32x4& v, int e) { const unsigned w = v[e >> 1]; return __uint_as_float((e & 1) ? (w & 0xffff0000u) : (w << 16)); }
__device__ __forceinline__ bf16_t bfr(const u32x4& v, int e) { const unsigned w = v[e >> 1]; return (bf16_t)((e & 1) ? (w >> 16) : (w & 0xffffu)); }
__device__ __forceinline__ float logsig(float x) { return fminf(x, 0.f) - log1pf(__expf(-fabsf(x))); }
__device__ __forceinline__ float softplusf(float x) { return fmaxf(x, 0.f) + log1pf(__expf(-fabsf(x))); }
__device__ __forceinline__ float sigm(float x) { return __builtin_amdgcn_rcpf(1.f + __expf(-x)); }
__device__ __forceinline__ float wave_sum(float v) {
#pragma unroll
    for (int o = 32; o >= 1; o >>= 1) v += __shfl_xor(v, o);
    return v; }
__device__ __forceinline__ float wave_max(float v) {
#pragma unroll
    for (int o = 32; o >= 1; o >>= 1) v = fmaxf(v, __shfl_xor(v, o));
    return v; }
__device__ __forceinline__ float wave_scan_add(float v, int lane) {
#pragma unroll
    for (int o = 1; o < 64; o <<= 1) { const float t = __shfl_up(v, o); if (lane >= o) v += t; }
    return v; }
__device__ __forceinline__ float wave_scan_max(float v, int lane) {
#pragma unroll
    for (int o = 1; o < 64; o <<= 1) { const float t = __shfl_up(v, o); if (lane >= o) v = fmaxf(v, t); }
    return v; }
__device__ __forceinline__ f32x4 mma(bf16x8 a, bf16x8 b, f32x4 c) { return __builtin_amdgcn_mfma_f32_16x16x32_bf16(a, b, c, 0, 0, 0); }
__device__ __forceinline__ bf16x8 ldsfrag(const LAS bf16_t* base, int row0, int ld, int k0, int lane) {
    return *(const LAS bf16x8*)(base + (row0 + (lane & 15)) * ld + k0 + (lane >> 4) * 8); }

__device__ __forceinline__ bf16x8 ldsfrag_swz(const LAS bf16_t* base, int row0, int ld, int k0, int lane) {
    const int row = row0 + (lane & 15), k = k0 + (lane >> 4) * 8;
    return *(const LAS bf16x8*)(base + row * ld + (k ^ (((row >> 3) & 7) << 3))); }

#define XB_TMO      128
#define XB_XCNT(j)  (256  + 64 * (j))
#define XB_XSUB(j)  (1280 + 64 * (j))
#define XB_XGEN(j)  (2304 + 64 * (j))
#define XB_TOP      3328
#define XB_TOPGEN   3392
#define XCD_BAR_WORDS 3456
#define XB_SPIN_CAP (1u << 18)
__device__ __forceinline__ unsigned xb_ld(unsigned* p)              { return __hip_atomic_load(p, __ATOMIC_RELAXED, __HIP_MEMORY_SCOPE_AGENT); }
__device__ __forceinline__ unsigned xb_add(unsigned* p, unsigned v) { return __hip_atomic_fetch_add(p, v, __ATOMIC_RELAXED, __HIP_MEMORY_SCOPE_AGENT); }
__device__ __forceinline__ unsigned xb_xcc_id() { return (unsigned)__builtin_amdgcn_s_getreg((3 << 11) | 20) & 0xFu; }
#define XB_SPIN(cond, bar) do { unsigned _sp = 0; while (cond) { __builtin_amdgcn_s_sleep(1); \
    if ((++_sp & 255u) == 0u) { if (xb_ld(&(bar)[XB_TMO])) break; if (_sp > XB_SPIN_CAP) { atomicAdd(&(bar)[XB_TMO], 1u); break; } } } } while (0)
struct XcdBarrier { unsigned* bar; unsigned x; volatile LAS unsigned* st; };
__device__ __forceinline__ XcdBarrier xcd_barrier_post(unsigned* bar, volatile LAS unsigned* st) {
    XcdBarrier b; b.bar = bar; b.x = xb_xcc_id(); b.st = st;
    if (threadIdx.x == 0) (void)xb_add(&bar[XB_XCNT(b.x)], 1u);
    return b;
}
__device__ __forceinline__ void xcd_barrier_complete(unsigned* bar, unsigned x, unsigned& nloc, unsigned& nx) {
    const unsigned G = gridDim.x * gridDim.y * gridDim.z;
    unsigned sum, cnt, mine, sp = 0u;
    for (;;) {
        sum = 0u; cnt = 0u; mine = 0u;
#pragma unroll
        for (unsigned j = 0; j < 16; ++j) { const unsigned c = xb_ld(&bar[XB_XCNT(j)]); sum += c; cnt += (c > 0u) ? 1u : 0u; mine = (j == x) ? c : mine; }
        if (sum == G) break;
        __builtin_amdgcn_s_sleep(1);
        if ((++sp & 255u) == 0u) { if (xb_ld(&bar[XB_TMO])) break; if (sp > XB_SPIN_CAP) { atomicAdd(&bar[XB_TMO], 1u); break; } }
    }
    nloc = mine > 0u ? mine : 1u; nx = cnt > 0u ? cnt : 1u;
}
__device__ __forceinline__ void xcd_barrier(const XcdBarrier& b) {
    asm volatile("s_waitcnt vmcnt(0)" ::: "memory");
    __syncthreads();
    if (threadIdx.x == 0) {
        unsigned* bar = b.bar;
        __builtin_amdgcn_s_waitcnt(0);
        unsigned nloc = b.st[0], nx = b.st[1];
        if (nloc == 0u) { xcd_barrier_complete(bar, b.x, nloc, nx); b.st[0] = nloc; b.st[1] = nx; }
        const unsigned old = xb_add(&bar[XB_XSUB(b.x)], 1u);
        const unsigned gen = old / nloc;
        if (old + 1u == (gen + 1u) * nloc) {
            __builtin_amdgcn_fence(__ATOMIC_RELEASE, "agent");
            asm volatile("s_waitcnt vmcnt(0)" ::: "memory");
            const unsigned og = xb_add(&bar[XB_TOP], 1u);
            const unsigned tg = og / nx;
            if (og + 1u == (tg + 1u) * nx) xb_add(&bar[XB_TOPGEN], 1u);
            else XB_SPIN(xb_ld(&bar[XB_TOPGEN]) == tg, bar);
            __builtin_amdgcn_fence(__ATOMIC_ACQUIRE, "agent");
            xb_add(&bar[XB_XGEN(b.x)], 1u);
            asm volatile("s_waitcnt vmcnt(0)" ::: "memory");
        } else {
            XB_SPIN(xb_ld(&bar[XB_XGEN(b.x)]) == gen, bar);
            __builtin_amdgcn_fence(__ATOMIC_ACQUIRE, "agent");
            asm volatile("s_waitcnt vmcnt(0)" ::: "memory");
        }
    }
    __syncthreads();
}

__device__ __forceinline__ void p0_prologue(const Params& P, LAS unsigned char* lds) {
    const int tid = otid();
    LAS float* tileb = (LAS float*)lds;
#define P0_DECODE(t, src_, dst_, K_, ldS_, k0_, n0_, sc_) do { int r_, sp_ = 0; \
        if ((t) < 768)       { const int j_ = (t) / 384; r_ = (t) % 384; src_ = P.in[8] + (size_t)j_ * 1024 * ABSRC; ldS_ = ABSRC; K_ = 1024; dst_ = (bf16_t*)(P.ws + WS_WABIN) + (size_t)j_ * ABN * 1024; sp_ = 1; } \
        else if ((t) < 1024) { const int q_ = (t) - 768, j_ = q_ / 128; r_ = q_ % 128; src_ = P.in[15] + (size_t)j_ * 1024 * 1024; ldS_ = 1024; K_ = 1024; dst_ = (bf16_t*)(P.ws + WS_WABOUT) + (size_t)j_ * 1024 * 1024; } \
        else if ((t) < 2304) { const int q_ = (t) - 1024, j_ = q_ / 640; r_ = q_ % 640; src_ = P.in[16] + (size_t)j_ * 1024 * SSDSRC; ldS_ = SSDSRC; K_ = 1024; dst_ = (bf16_t*)(P.ws + WS_WSSDIN) + (size_t)j_ * SSDN * 1024; } \
        else if ((t) < 2816) { const int q_ = (t) - 2304, j_ = q_ / 256; r_ = q_ % 256; src_ = P.in[23] + (size_t)j_ * 2048 * 1024; ldS_ = 1024; K_ = 2048; dst_ = (bf16_t*)(P.ws + WS_WSSDOUT) + (size_t)j_ * 1024 * 2048; } \
        else if ((t) < 4864) { const int q_ = (t) - 2816, l_ = q_ / 512; r_ = q_ % 512; src_ = P.in[24] + (size_t)l_ * 1024 * 4096; ldS_ = 4096; K_ = 1024; dst_ = (bf16_t*)(P.ws + WS_W1) + (size_t)l_ * 4096 * 1024; } \
        else                 { const int q_ = (t) - 4864, l_ = q_ / 512; r_ = q_ % 512; src_ = P.in[25] + (size_t)l_ * 4096 * 1024; ldS_ = 1024; K_ = 4096; dst_ = (bf16_t*)(P.ws + WS_W2) + (size_t)l_ * 1024 * 4096; } \
        const int nkt_ = K_ >> 7; k0_ = (r_ % nkt_) * 128; n0_ = (r_ / nkt_) * 64; sc_ = n0_ + ((sp_ && n0_ >= 1536) ? 8 : 0); } while (0)
    {
        constexpr int NT0 = 6912;
        const int rr = tid >> 4, c4 = (tid & 15) * 4;
        const int G2 = gridDim.x;
        f32x4 va[4], vb[4];
#pragma unroll
        for (int q = 0; q < 4; ++q) { va[q] = (f32x4){0.f, 0.f, 0.f, 0.f}; vb[q] = (f32x4){0.f, 0.f, 0.f, 0.f}; }
        const float* src; int ldS, sc;
        bf16_t* dstA = nullptr; int KA = 0, k0A = 0, n0A = 0; bf16_t* dstB = nullptr; int KB = 0, k0B = 0, n0B = 0;
        int tA = blockIdx.x, tB = blockIdx.x + G2;
        if (tA < NT0) { P0_DECODE(tA, src, dstA, KA, ldS, k0A, n0A, sc);
#pragma unroll
            for (int q = 0; q < 4; ++q) va[q] = *(const f32x4*)(src + (size_t)(k0A + rr + 32 * q) * ldS + sc + c4); }
        if (tB < NT0) { P0_DECODE(tB, src, dstB, KB, ldS, k0B, n0B, sc);
#pragma unroll
            for (int q = 0; q < 4; ++q) vb[q] = *(const f32x4*)(src + (size_t)(k0B + rr + 32 * q) * ldS + sc + c4); }
#define P0_STEP(V, DST, KK, K0, N0, TT, BUF) do { \
            LAS float* tile_ = tileb + (BUF) * (128 * 65); \
            _Pragma("unroll") for (int q = 0; q < 4; ++q) { const int k_ = rr + 32 * q; tile_[k_ * 65 + c4 + 0] = V[q][0]; tile_[k_ * 65 + c4 + 1] = V[q][1]; tile_[k_ * 65 + c4 + 2] = V[q][2]; tile_[k_ * 65 + c4 + 3] = V[q][3]; } \
            bf16_t* cdst_ = DST; const int cK_ = KK, ck0_ = K0, cn0_ = N0; \
            TT += 2 * G2; \
            if (TT < NT0) { P0_DECODE(TT, src, DST, KK, ldS, K0, N0, sc); \
                _Pragma("unroll") for (int q = 0; q < 4; ++q) V[q] = *(const f32x4*)(src + (size_t)(K0 + rr + 32 * q) * ldS + sc + c4); } \
            __syncthreads(); \
            { const int n_ = tid >> 3, kv_ = (tid & 7) * 8; u32x4 w0_, w1_;     \
              w0_.x = pk2(tile_[(kv_ + 0) * 65 + n_], tile_[(kv_ + 1) * 65 + n_]); w0_.y = pk2(tile_[(kv_ + 2) * 65 + n_], tile_[(kv_ + 3) * 65 + n_]); \
              w0_.z = pk2(tile_[(kv_ + 4) * 65 + n_], tile_[(kv_ + 5) * 65 + n_]); w0_.w = pk2(tile_[(kv_ + 6) * 65 + n_], tile_[(kv_ + 7) * 65 + n_]); \
              w1_.x = pk2(tile_[(kv_ + 64) * 65 + n_], tile_[(kv_ + 65) * 65 + n_]); w1_.y = pk2(tile_[(kv_ + 66) * 65 + n_], tile_[(kv_ + 67) * 65 + n_]); \
              w1_.z = pk2(tile_[(kv_ + 68) * 65 + n_], tile_[(kv_ + 69) * 65 + n_]); w1_.w = pk2(tile_[(kv_ + 70) * 65 + n_], tile_[(kv_ + 71) * 65 + n_]); \
              bf16_t* dp_ = cdst_ + (size_t)(cn0_ + n_) * cK_ + ck0_ + kv_; *(u32x4*)dp_ = w0_; *(u32x4*)(dp_ + 64) = w1_; } } while (0)
#pragma unroll 1
        while (tA < NT0) {
            P0_STEP(va, dstA, KA, k0A, n0A, tA, 0);
            if (tB < NT0) P0_STEP(vb, dstB, KB, k0B, n0B, tB, 1);
        }
#undef P0_STEP
    }
#undef P0_DECODE
    const int gtid = blockIdx.x * 512 + tid, gsz = gridDim.x * 512;
    for (int idx = gtid; idx < 4 * 32 * 1024; idx += gsz) {
        const int which = idx >> 15, n = (idx >> 10) & 31, k = idx & 1023; float v = 0.f;
        if (which < 2) { const int col = n < 4 ? 1536 + n : (n < 8 ? 1540 + (n - 4) : (n < 24 ? 3080 + (n - 8) : -1));
            if (col >= 0) v = P.in[8][((size_t)which * 1024 + k) * ABSRC + col];
            ((bf16_t*)(P.ws + WS_WABG))[(size_t)which * 32768 + n * 1024 + k] = f2bf(v); }
        else { const int j = which - 2; v = P.in[16][((size_t)j * 1024 + k) * SSDSRC + 5120 + n];
            ((bf16_t*)(P.ws + WS_WSSDG))[(size_t)j * 32768 + n * 1024 + k] = f2bf(v); }
    }
    { const f32x4* xp = (const f32x4*)P.in[0]; const f32x4* xs = (const f32x4*)P.in[1]; u32x2* XB = (u32x2*)(P.ws + WS_XB);
      for (int idx0 = gtid; idx0 < MT * 256; idx0 += 4 * gsz) { f32x4 v[4];
#pragma unroll
          for (int q = 0; q < 4; ++q) { const int idx = idx0 + q * gsz; if (idx < MT * 256) v[q] = idx < MP * 256 ? xp[idx] : xs[idx - MP * 256]; }
#pragma unroll
          for (int q = 0; q < 4; ++q) { const int idx = idx0 + q * gsz; if (idx < MT * 256) { u32x2 w; w.x = pk2(v[q][0], v[q][1]); w.y = pk2(v[q][2], v[q][3]); XB[idx] = w; } } } }
}

__device__ __forceinline__ void gates_phase(LAS unsigned char* lds, const bf16_t* XB, const bf16_t* Gt, float* GT) {
    const int tid = otid(), lane = tid & 63, wave = __builtin_amdgcn_readfirstlane(tid >> 6);
    const int gw = blockIdx.x * 8 + wave, nw = gridDim.x * 8;
    LAS bf16_t* stg = (LAS bf16_t*)(lds + wave * 6912);
    const int lr = lane >> 3, lc = (lane & 7) * 8;
    for (int task = gw; task < MT / 16; task += nw) {
        const int m0 = task * 16;
        f32x4 a0 = {0.f, 0.f, 0.f, 0.f}, a1 = {0.f, 0.f, 0.f, 0.f};
        const bf16_t* ap = XB + (size_t)(m0 + lr) * 1024 + lc;
        const bf16_t* bp = Gt + (size_t)lr * 1024 + lc;
        u32x4 g[6];
#pragma unroll
        for (int i = 0; i < 2; ++i) g[i] = *(const u32x4*)(ap + (size_t)(i * 8) * 1024);
#pragma unroll
        for (int i = 0; i < 4; ++i) g[2 + i] = *(const u32x4*)(bp + (size_t)(i * 8) * 1024);
#pragma unroll 1
        for (int kb = 0; kb < 16; ++kb) {
#pragma unroll
            for (int i = 0; i < 6; ++i) *(LAS u32x4*)(stg + (i * 8 + lr) * 72 + lc) = g[i];
            if (kb + 1 < 16) {
#pragma unroll
                for (int i = 0; i < 2; ++i) g[i] = *(const u32x4*)(ap + (size_t)(i * 8) * 1024 + (kb + 1) * 64);
#pragma unroll
                for (int i = 0; i < 4; ++i) g[2 + i] = *(const u32x4*)(bp + (size_t)(i * 8) * 1024 + (kb + 1) * 64);
            }
#pragma unroll
            for (int q = 0; q < 2; ++q) { const bf16x8 a = ldsfrag(stg, 0, 72, q * 32, lane), b0 = ldsfrag(stg, 16, 72, q * 32, lane), b1 = ldsfrag(stg, 32, 72, q * 32, lane);
                a0 = mma(a, b0, a0); a1 = mma(a, b1, a1); }
        }
#pragma unroll
        for (int r = 0; r < 4; ++r) { const int row = m0 + (lane >> 4) * 4 + r; GT[(size_t)(lane & 15) * MT + row] = a0[r]; GT[(size_t)(16 + (lane & 15)) * MT + row] = a1[r]; }
    }
    __syncthreads();
}

__device__ __forceinline__ void ln_phase(const bf16_t* Y, const float* g, const float* bta, float* OUT, bf16_t* XB) {
    const int tid = otid(), lane = tid & 63, wave = tid >> 6;
    const int gw = blockIdx.x * 8 + wave, nw = gridDim.x * 8;
    const int sub = lane >> 4, l16 = lane & 15;
    for (int row0 = gw * 4; row0 < MT; row0 += nw * 4) {
        const int row = row0 + sub;
        const bf16_t* yr = Y + (size_t)row * 1024;
        u32x4 yv[8]; float s = 0.f;
#pragma unroll
        for (int k = 0; k < 8; ++k) yv[k] = *(const u32x4*)(yr + (l16 + 16 * k) * 8);
#pragma unroll
        for (int k = 0; k < 8; ++k)
#pragma unroll
            for (int e = 0; e < 8; ++e) s += bfe(yv[k], e);
        s += __shfl_xor(s, 1); s += __shfl_xor(s, 2); s += __shfl_xor(s, 4); s += __shfl_xor(s, 8);
        const float mean = s * (1.f / 1024.f); float q = 0.f;
#pragma unroll
        for (int k = 0; k < 8; ++k)
#pragma unroll
            for (int e = 0; e < 8; ++e) { const float d = bfe(yv[k], e) - mean; q += d * d; }
        q += __shfl_xor(q, 1); q += __shfl_xor(q, 2); q += __shfl_xor(q, 4); q += __shfl_xor(q, 8);
        const float rstd = rsqrtf(q * (1.f / 1024.f) + LN_EPS);
#pragma unroll
        for (int k = 0; k < 8; ++k) { const int col = (l16 + 16 * k) * 8;
            const f32x4 g0 = *(const f32x4*)(g + col), g1 = *(const f32x4*)(g + col + 4), b0 = *(const f32x4*)(bta + col), b1 = *(const f32x4*)(bta + col + 4);
            f32x4 o0, o1;
#pragma unroll
            for (int e = 0; e < 4; ++e) { o0[e] = (bfe(yv[k], e) - mean) * rstd * g0[e] + b0[e]; o1[e] = (bfe(yv[k], 4 + e) - mean) * rstd * g1[e] + b1[e]; }
            if (OUT) { *(f32x4*)(OUT + (size_t)row * 1024 + col) = o0; *(f32x4*)(OUT + (size_t)row * 1024 + col + 4) = o1; }
            else { u32x4 w; w.x = pk2(o0[0], o0[1]); w.y = pk2(o0[2], o0[3]); w.z = pk2(o1[0], o1[1]); w.w = pk2(o1[2], o1[3]);
                *(u32x4*)(XB + (size_t)row * 1024 + col) = w; } }
    }
}

struct AbItem { int samp, b, h, c, m0, nvalid; };
__device__ __forceinline__ AbItem ab_decode(int i) {
    AbItem t; t.samp = i >= 1024;
    if (!t.samp) { t.b = i >> 7; t.h = (i >> 5) & 3; t.c = i & 31; t.m0 = t.b * 2048 + t.c * 64; t.nvalid = 64; }
    else { const int r = i - 1024; t.b = r >> 2; t.h = r & 3; t.c = 0; t.m0 = MP + t.b * 4; t.nvalid = 4; }
    return t;
}
__device__ __forceinline__ void write_vt(LAS bf16_t* VT, const u32x4& a, const u32x4& b, int tid) {
    const int c16 = tid & 15, s0 = (2 * (tid >> 4)) ^ ((c16 & 7) << 3);
#pragma unroll
    for (int e = 0; e < 8; ++e) *(LAS unsigned*)(VT + (c16 * 8 + e) * 72 + s0) = (unsigned)bfr(a, e) | ((unsigned)bfr(b, e) << 16);
}

template <int TYPE> __device__ __forceinline__ void ab_delta_item(const Params& P, LAS unsigned char* lds, int j, int i) {
    const int tid = otid(), lane = tid & 63, wave = __builtin_amdgcn_readfirstlane(tid >> 6);
    const AbItem it = ab_decode(i);
    const int b = it.b, h = it.h, c = it.c, m0 = it.m0, nvalid = it.nvalid;
    LAS bf16_t* KT = (LAS bf16_t*)lds; LAS bf16_t* VT = (LAS bf16_t*)(lds + 9216);
    const bf16_t* Pb = (const bf16_t*)(P.ws + WS_P);
    const float* GT = (const float*)(P.ws + WS_GT);
    const int kcol = TYPE == 0 ? 256 + h * 64 : 1792 + h * 64, vcol = TYPE == 0 ? 512 + h * 128 : 2048 + h * 128;
    const int ls = tid >> 3, ld8 = (tid & 7) * 8, lv16 = (tid & 7) * 16;
    u32x4 kv = {0u, 0u, 0u, 0u}, va = {0u, 0u, 0u, 0u}, vb = {0u, 0u, 0u, 0u};
    if (ls < nvalid) { const bf16_t* rowp = Pb + (size_t)(m0 + ls) * ABN; kv = *(const u32x4*)(rowp + kcol + ld8); }
    { const int vr = 2 * (tid >> 4), vc = (tid & 15) * 8;
      if (vr < nvalid) va = *(const u32x4*)(Pb + (size_t)(m0 + vr) * ABN + vcol + vc);
      if (vr + 1 < nvalid) vb = *(const u32x4*)(Pb + (size_t)(m0 + vr + 1) * ABN + vcol + vc); }
    if (TYPE == 0) {
        LAS float* bt = (LAS float*)(lds + 27648); LAS float* igt = bt + 64; LAS float* scb = bt + 128; LAS float* sca = bt + 160;
        const float igb = P.in[9][j * 4 + h], fgb = P.in[10][j * 4 + h];
        float mprev = it.samp ? P.in[4][(j * 128 + b) * 4 + h] : 0.f;
        const bool valid = lane < nvalid;
        float pf[4], pi[4];
#pragma unroll
        for (int q = 0; q < 4; ++q) { const int cc = wave + 8 * q; pf[q] = 0.f; pi[q] = 0.f;
            if (cc <= c && valid) { const int row = (it.samp ? m0 : b * 2048 + cc * 64) + lane; pf[q] = GT[(size_t)(4 + h) * MT + row]; pi[q] = GT[(size_t)h * MT + row]; } }
#pragma unroll
        for (int q = 0; q < 4; ++q) { const int cc = wave + 8 * q;
            if (cc <= c) {
                const float lf = valid ? logsig(pf[q] + fgb) : 0.f, ig = valid ? pi[q] + igb : -INFINITY;
                const float bs = wave_scan_add(lf, lane); const float am = wave_max(ig - bs);
                if (cc == c) { bt[lane] = bs; igt[lane] = ig; }
                if (lane == 63) scb[cc] = bs;
                if (lane == 0) sca[cc] = am;
            } }
        __syncthreads();
        for (int cc = 0; cc < c; ++cc) mprev = scb[cc] + fmaxf(mprev, sca[cc]);
        const float bL = scb[c], aL = sca[c]; const float mL = bL + fmaxf(mprev, aL); const float wL0 = __expf(bL + mprev - mL);
        { float wl = 0.f; if (ls < nvalid) wl = 0.125f * __expf(bL - bt[ls] + igt[ls] - mL);
#pragma unroll
          for (int e = 0; e < 8; ++e) KT[(ld8 + e) * 72 + (ls ^ ld8)] = f2bf(bfe(kv, e) * wl); }
        if (tid == 0) { float* sc = (float*)(P.ws + WS_SCAL) + (size_t)i * 4; sc[0] = mprev; sc[1] = wL0; sc[2] = mL;
            if (it.samp) P.out[O_SM + (j * 128 + b) * 4 + h] = mL; else if (c == 31) P.out[O_PM + (j * 8 + b) * 4 + h] = mL; }
    } else {
        LAS float* gaL = (LAS float*)(lds + 28672); LAS float* Ac = (LAS float*)(lds + 32768); LAS float* seg = (LAS float*)(lds + 49408);
        const int dk = tid & 63, sg = tid >> 6;
        float g2v[2];
#pragma unroll
        for (int q = 0; q < 2; ++q) { const int idx = tid + q * 512, r = idx >> 6, s = idx & 63; g2v[q] = (s < nvalid) ? GT[(size_t)(8 + r) * MT + m0 + s] : 0.f; }
        float wcv[16];
#pragma unroll
        for (int r = 0; r < 16; ++r) wcv[r] = P.in[12][(size_t)(j * 16 + r) * 256 + h * 64 + dk];
        const float bias = P.in[13][j * 256 + h * 64 + dk];
        gaL[tid] = g2v[0]; gaL[tid + 512] = g2v[1];
        __syncthreads();
        float loc[8]; float run = 0.f;
#pragma unroll
        for (int ss = 0; ss < 8; ++ss) { const int s = sg * 8 + ss; float la = 0.f;
            if (s < nvalid) { float z = bias;
#pragma unroll
                for (int r = 0; r < 16; ++r) z += gaL[r * 64 + s] * wcv[r];
                la = logsig(z) * (1.f / 16.f); }
            run += la; loc[ss] = run; }
        seg[sg * 64 + dk] = run;
        __syncthreads();
        float off = 0.f;
#pragma unroll
        for (int g2 = 0; g2 < 8; ++g2) off += (g2 < sg) ? seg[g2 * 64 + dk] : 0.f;
        float* acg = (float*)(P.ws + WS_ACUM) + (size_t)i * 4096;
#pragma unroll
        for (int ss = 0; ss < 8; ++ss) { const int s = sg * 8 + ss; const float a = loc[ss] + off; Ac[s * 65 + dk] = a; acg[s * 64 + dk] = a; }
        __syncthreads();
#pragma unroll
        for (int e = 0; e < 8; ++e) { const int d = ld8 + e; const float wgt = __expf(Ac[63 * 65 + d] - Ac[ls * 65 + d]); KT[d * 72 + (ls ^ ld8)] = f2bf(bfe(kv, e) * wgt); }
        if (tid < 64) ((float*)(P.ws + WS_DEC))[(size_t)i * 64 + tid] = __expf(Ac[63 * 65 + tid]);
    }
    write_vt(VT, va, vb, tid);
    __syncthreads();
    f32x4 acc[4];
#pragma unroll
    for (int jj = 0; jj < 4; ++jj) acc[jj] = (f32x4){0.f, 0.f, 0.f, 0.f};
#pragma unroll
    for (int ks = 0; ks < 2; ++ks) { const bf16x8 a = ldsfrag_swz(VT, wave * 16, 72, ks * 32, lane);
#pragma unroll
        for (int jj = 0; jj < 4; ++jj) { const bf16x8 bb = ldsfrag_swz(KT, jj * 16, 72, ks * 32, lane); acc[jj] = mma(a, bb, acc[jj]); } }
    float* dct = (float*)(P.ws + WS_DCT) + (size_t)(TYPE * NITEM + i) * 8192;
#pragma unroll
    for (int jj = 0; jj < 4; ++jj)
#pragma unroll
        for (int r = 0; r < 4; ++r) dct[(wave * 16 + (lane >> 4) * 4 + r) * 64 + jj * 16 + (lane & 15)] = acc[jj][r];
    if (TYPE == 0 && tid < 64) { float sa = 0.f;
#pragma unroll 8
        for (int s = 0; s < 64; s += 8) { const u32x4 kk = *(const LAS u32x4*)(KT + tid * 72 + s);
#pragma unroll
            for (int e = 0; e < 8; ++e) sa += bfe(kk, e); }
        ((float*)(P.ws + WS_DN))[(size_t)i * 64 + tid] = sa; }
    __syncthreads();
}

__device__ __forceinline__ void ab_scan_phase(const Params& P, LAS unsigned char* lds, int j) {
    const int tid = otid();
    const float* DCT = (const float*)(P.ws + WS_DCT); bf16_t* CINT = (bf16_t*)(P.ws + WS_CINT);
    const float* SCAL = (const float*)(P.ws + WS_SCAL); const float* DEC = (const float*)(P.ws + WS_DEC);
    const float* DN = (const float*)(P.ws + WS_DN); float* NIN = (float*)(P.ws + WS_NIN);
    for (int task = blockIdx.x; task < 256 + 1024; task += gridDim.x) {
        if (task < 256) {
            const int type = task >> 7, seq = (task >> 2) & 31, q = task & 3, b = seq >> 2, h = seq & 3;
            const int e = q * 2048 + tid * 4;
            f32x4 st = {0.f, 0.f, 0.f, 0.f};
#pragma unroll 8
            for (int c = 0; c < 32; ++c) { const int i = seq * 32 + c; const size_t base = (size_t)(type * NITEM + i) * 8192 + e;
                const f32x4 d = *(const f32x4*)(DCT + base);
                f32x4 dec; if (type == 0) { const float w = SCAL[i * 4 + 1]; dec = (f32x4){w, w, w, w}; } else dec = *(const f32x4*)(DEC + (size_t)i * 64 + (e & 63));
                u32x2 w2; w2.x = pk2(st[0], st[1]); w2.y = pk2(st[2], st[3]); *(u32x2*)(CINT + base) = w2;
                st = dec * st + d; }
            float* out = P.out + (type == 0 ? O_PC : O_PS) + (size_t)((j * 8 + b) * 4 + h) * 8192;
            const int dv = e >> 6, dk = e & 63;
#pragma unroll
            for (int jj = 0; jj < 4; ++jj) out[(dk + jj) * 128 + dv] = st[jj];
            if (type == 0 && q == 0 && tid < 64) { float ns = 0.f;
#pragma unroll 1
                for (int c0 = 0; c0 < 32; c0 += 8) { float wv[8], dv8[8];
#pragma unroll
                    for (int u = 0; u < 8; ++u) { const int i = seq * 32 + c0 + u; wv[u] = SCAL[i * 4 + 1]; dv8[u] = DN[(size_t)i * 64 + tid]; }
#pragma unroll
                    for (int u = 0; u < 8; ++u) { const int i = seq * 32 + c0 + u; NIN[(size_t)i * 64 + tid] = ns; ns = wv[u] * ns + dv8[u]; } }
                P.out[O_PN + (size_t)((j * 8 + b) * 4 + h) * 64 + tid] = ns; }
        } else {
            const int r = task - 256, type = r >> 9, bh = r & 511, b = bh >> 2, h = bh & 3, i = 1024 + bh;
            LAS float* T1 = (LAS float*)lds; LAS float* T2 = (LAS float*)(lds + 33280);
            const size_t base = (size_t)(type * NITEM + i) * 8192;
#pragma unroll
            for (int k = 0; k < 4; ++k) { const int e = tid * 4 + k * 2048; const f32x4 d = *(const f32x4*)(DCT + base + e); const int dv = e >> 6, dk = e & 63;
                T1[dv * 65 + dk] = d[0]; T1[dv * 65 + dk + 1] = d[1]; T1[dv * 65 + dk + 2] = d[2]; T1[dv * 65 + dk + 3] = d[3]; }
            const float* sin = (type == 0 ? P.in[2] : P.in[5]) + (size_t)((j * 128 + b) * 4 + h) * 8192;
            float* sout = P.out + (type == 0 ? O_SC : O_SS) + (size_t)((j * 128 + b) * 4 + h) * 8192;
            const float wl0 = SCAL[i * 4 + 1];
            f32x4 s0v[4]; float decv[4];
#pragma unroll
            for (int k = 0; k < 4; ++k) { const int e2 = tid * 4 + k * 2048; s0v[k] = *(const f32x4*)(sin + e2); decv[k] = type == 0 ? wl0 : DEC[(size_t)i * 64 + (e2 >> 7)]; }
            __syncthreads();
#pragma unroll
            for (int k = 0; k < 4; ++k) { const int e2 = tid * 4 + k * 2048; const int dk = e2 >> 7, dv = e2 & 127; const f32x4 s0 = s0v[k];
                const float dec = decv[k]; f32x4 nv;
#pragma unroll
                for (int jj = 0; jj < 4; ++jj) { nv[jj] = dec * s0[jj] + T1[(dv + jj) * 65 + dk]; T2[dk * 129 + dv + jj] = s0[jj]; }
                *(f32x4*)(sout + e2) = nv; }
            __syncthreads();
#pragma unroll
            for (int k = 0; k < 4; ++k) { const int e = tid * 4 + k * 2048; const int dv = e >> 6, dk = e & 63; u32x2 w2;
                w2.x = pk2(T2[dk * 129 + dv], T2[(dk + 1) * 129 + dv]); w2.y = pk2(T2[(dk + 2) * 129 + dv], T2[(dk + 3) * 129 + dv]); *(u32x2*)(CINT + base + e) = w2; }
            if (type == 0 && tid < 64) { const float n0 = P.in[3][(size_t)((j * 128 + b) * 4 + h) * 64 + tid]; NIN[(size_t)i * 64 + tid] = n0;
                P.out[O_SN + (size_t)((j * 128 + b) * 4 + h) * 64 + tid] = wl0 * n0 + DN[(size_t)i * 64 + tid]; }
            __syncthreads();
        }
    }
}

template <int TYPE> __device__ __forceinline__ void ab_out_item(const Params& P, LAS unsigned char* lds, int j, int i) {
    const int tid = otid(), lane = tid & 63, wave = __builtin_amdgcn_readfirstlane(tid >> 6);
    const AbItem it = ab_decode(i);
    const int h = it.h, m0 = it.m0, nvalid = it.nvalid;
    LAS bf16_t* Q = (LAS bf16_t*)lds; LAS bf16_t* Kx = (LAS bf16_t*)(lds + 9216); LAS bf16_t* VT = (LAS bf16_t*)(lds + 18432); LAS bf16_t* C0T = (LAS bf16_t*)(lds + 36864);
    LAS bf16_t* Sw = (LAS bf16_t*)(lds + 55296); LAS float* Ob = (LAS float*)(lds + 64512);
    LAS float* bt = (LAS float*)(lds + 98304); LAS float* igt = bt + 64; LAS float* mt = bt + 128; LAS float* wint = bt + 192; LAS float* rden = bt + 256; LAS float* n0L = bt + 320;
    LAS float* Ac = (LAS float*)(lds + 99840);
    const bf16_t* Pb = (const bf16_t*)(P.ws + WS_P);
    const float* GT = (const float*)(P.ws + WS_GT);
    const int qcol = TYPE == 0 ? h * 64 : 1536 + h * 64, kcol = TYPE == 0 ? 256 + h * 64 : 1792 + h * 64, vcol = TYPE == 0 ? 512 + h * 128 : 2048 + h * 128, gcol = TYPE == 0 ? 1024 + h * 128 : 2560 + h * 128;
    const int ls = tid >> 3, ld8 = (tid & 7) * 8, lv16 = (tid & 7) * 16;
    u32x4 qv = {0u, 0u, 0u, 0u}, kv = {0u, 0u, 0u, 0u}, va = {0u, 0u, 0u, 0u}, vb = {0u, 0u, 0u, 0u};
    if (ls < nvalid) { const bf16_t* rowp = Pb + (size_t)(m0 + ls) * ABN; qv = *(const u32x4*)(rowp + qcol + ld8); kv = *(const u32x4*)(rowp + kcol + ld8);
        }
    { const int vr = 2 * (tid >> 4), vc = (tid & 15) * 8;
      if (vr < nvalid) va = *(const u32x4*)(Pb + (size_t)(m0 + vr) * ABN + vcol + vc);
      if (vr + 1 < nvalid) vb = *(const u32x4*)(Pb + (size_t)(m0 + vr + 1) * ABN + vcol + vc); }
    const int crow = tid >> 3, csg = (tid & 7) * 8;
    const bf16_t* csrc = (const bf16_t*)(P.ws + WS_CINT) + (size_t)(TYPE * NITEM + i) * 8192 + crow * 64 + csg;
    const u32x4 c0a = *(const u32x4*)csrc, c0b = *(const u32x4*)(csrc + 64 * 64);
    const int nt_ = tid >> 3, nsg = tid & 7;
    u32x4 gpa = {0u, 0u, 0u, 0u}, gpb = {0u, 0u, 0u, 0u};
    if (nt_ < nvalid) { const bf16_t* gp = Pb + (size_t)(m0 + nt_) * ABN + gcol + nsg * 8; gpa = *(const u32x4*)gp; gpb = *(const u32x4*)(gp + 64); }
    const float* nrm = (TYPE == 0 ? P.in[11] : P.in[14]) + j * 512 + h * 128;
    float acv[8];
    if (TYPE == 0) {
        if (wave == 0) {
            const float igb = P.in[9][j * 4 + h], fgb = P.in[10][j * 4 + h];
            float lf = 0.f, ig = -INFINITY;
            if (lane < nvalid) { lf = logsig(GT[(size_t)(4 + h) * MT + m0 + lane] + fgb); ig = GT[(size_t)h * MT + m0 + lane] + igb; }
            const float mprev = ((const float*)(P.ws + WS_SCAL))[(size_t)i * 4];
            const float n0v = ((const float*)(P.ws + WS_NIN))[(size_t)i * 64 + lane];
            const float bs = wave_scan_add(lf, lane); const float am = wave_scan_max(ig - bs, lane);
            const float mtv = bs + fmaxf(mprev, am);
            bt[lane] = bs; igt[lane] = ig; mt[lane] = mtv; wint[lane] = __expf(bs + mprev - mtv); n0L[lane] = n0v;
        }
    } else {
        const float* acg = (const float*)(P.ws + WS_ACUM) + (size_t)i * 4096;
#pragma unroll
        for (int q = 0; q < 8; ++q) acv[q] = acg[tid + q * 512];
#pragma unroll
        for (int q = 0; q < 8; ++q) { const int idx = tid + q * 512; Ac[(idx >> 6) * 65 + (idx & 63)] = acv[q]; }
        __syncthreads();
    }
    { float qf[8], kf[8];
#pragma unroll
      for (int e = 0; e < 8; ++e) {
          if (TYPE == 0) { qf[e] = bfe(qv, e); kf[e] = bfe(kv, e) * 0.125f; }
          else { const float a = Ac[ls * 65 + ld8 + e]; qf[e] = bfe(qv, e) * 0.125f * __expf(a); kf[e] = bfe(kv, e) * __expf(-a); } }
      u32x4 qw, kw; qw.x = pk2(qf[0], qf[1]); qw.y = pk2(qf[2], qf[3]); qw.z = pk2(qf[4], qf[5]); qw.w = pk2(qf[6], qf[7]);
      kw.x = pk2(kf[0], kf[1]); kw.y = pk2(kf[2], kf[3]); kw.z = pk2(kf[4], kf[5]); kw.w = pk2(kf[6], kf[7]);
      *(LAS u32x4*)(Q + ls * 72 + ld8) = qw; *(LAS u32x4*)(Kx + ls * 72 + ld8) = kw; }
    write_vt(VT, va, vb, tid);
    *(LAS u32x4*)(C0T + crow * 72 + csg) = c0a; *(LAS u32x4*)(C0T + (64 + crow) * 72 + csg) = c0b;
    __syncthreads();
    { const int rt = wave >> 1, ct0 = (wave & 1) * 2;
      f32x4 sa[2] = {(f32x4){0.f, 0.f, 0.f, 0.f}, (f32x4){0.f, 0.f, 0.f, 0.f}};
#pragma unroll
      for (int ks = 0; ks < 2; ++ks) { const bf16x8 a = ldsfrag(Q, rt * 16, 72, ks * 32, lane);
#pragma unroll
          for (int jj = 0; jj < 2; ++jj) { const bf16x8 bb = ldsfrag(Kx, (ct0 + jj) * 16, 72, ks * 32, lane); sa[jj] = mma(a, bb, sa[jj]); } }
#pragma unroll
      for (int jj = 0; jj < 2; ++jj)
#pragma unroll
          for (int r = 0; r < 4; ++r) { const int t = rt * 16 + (lane >> 4) * 4 + r, s = (ct0 + jj) * 16 + (lane & 15); float v = 0.f;
              if (s <= t) { v = sa[jj][r]; if (TYPE == 0) v *= __expf(bt[t] - bt[s] + igt[s] - mt[t]); }
              Sw[t * 72 + s] = f2bf(v); } }
    __syncthreads();
    if (TYPE == 0 && tid < 64) {
        const int t = tid; float den = 0.f, qn = 0.f;
#pragma unroll
        for (int s = 0; s < 64; s += 8) { const u32x4 sv = *(const LAS u32x4*)(Sw + t * 72 + s), qq = *(const LAS u32x4*)(Q + t * 72 + s);
#pragma unroll
            for (int e = 0; e < 8; ++e) { den += bfe(sv, e); qn += bfe(qq, e) * n0L[s + e]; } }
        den += wint[t] * qn;
        rden[t] = 1.f / fmaxf(fabsf(den), __expf(-mt[t]));
    }
    { const int rt = wave >> 1, ct0 = (wave & 1) * 4;
      f32x4 o[4];
#pragma unroll
      for (int jj = 0; jj < 4; ++jj) o[jj] = (f32x4){0.f, 0.f, 0.f, 0.f};
#pragma unroll
      for (int ks = 0; ks < 2; ++ks) { const bf16x8 a = ldsfrag(Q, rt * 16, 72, ks * 32, lane);
#pragma unroll
          for (int jj = 0; jj < 4; ++jj) { const bf16x8 bb = ldsfrag(C0T, (ct0 + jj) * 16, 72, ks * 32, lane); o[jj] = mma(a, bb, o[jj]); } }
      if (TYPE == 0) {
#pragma unroll
          for (int r = 0; r < 4; ++r) { const float w = wint[rt * 16 + (lane >> 4) * 4 + r];
#pragma unroll
              for (int jj = 0; jj < 4; ++jj) o[jj][r] *= w; } }
#pragma unroll
      for (int ks = 0; ks < 2; ++ks) { const bf16x8 a = ldsfrag(Sw, rt * 16, 72, ks * 32, lane);
#pragma unroll
          for (int jj = 0; jj < 4; ++jj) { const bf16x8 bb = ldsfrag_swz(VT, (ct0 + jj) * 16, 72, ks * 32, lane); o[jj] = mma(a, bb, o[jj]); } }
#pragma unroll
      for (int jj = 0; jj < 4; ++jj)
#pragma unroll
          for (int r = 0; r < 4; ++r) Ob[(rt * 16 + (lane >> 4) * 4 + r) * 132 + (ct0 + jj) * 16 + (lane & 15)] = o[jj][r]; }
    __syncthreads();
    { bf16_t* MIXb = (bf16_t*)(P.ws + WS_MIX);
      const float rd = TYPE == 0 ? rden[nt_] : 1.f;
      float x[16]; float sm = 0.f;
#pragma unroll
      for (int q = 0; q < 4; ++q) { const f32x4 o4 = *(const LAS f32x4*)(Ob + nt_ * 132 + (q >> 1) * 64 + nsg * 8 + (q & 1) * 4);
#pragma unroll
          for (int e = 0; e < 4; ++e) { x[q * 4 + e] = o4[e] * rd; sm += x[q * 4 + e]; } }
      sm += __shfl_xor(sm, 1); sm += __shfl_xor(sm, 2); sm += __shfl_xor(sm, 4);
      const float mean = sm * (1.f / 128.f); float qv2 = 0.f;
#pragma unroll
      for (int e = 0; e < 16; ++e) { x[e] -= mean; qv2 += x[e] * x[e]; }
      qv2 += __shfl_xor(qv2, 1); qv2 += __shfl_xor(qv2, 2); qv2 += __shfl_xor(qv2, 4);
      const float rs = rsqrtf(qv2 * (1.f / 128.f) + LN_EPS);
      float o[16];
#pragma unroll
      for (int q = 0; q < 4; ++q) { const f32x4 gq = *(const f32x4*)(nrm + (q >> 1) * 64 + nsg * 8 + (q & 1) * 4);
#pragma unroll
          for (int e = 0; e < 4; ++e) { const int idx = q * 4 + e; const float p = idx < 8 ? bfe(gpa, idx & 7) : bfe(gpb, idx & 7);
              const float gate = TYPE == 0 ? sigm(p) : p * sigm(p); o[idx] = x[idx] * rs * gq[e] * gate; } }
      if (nt_ < nvalid) { u32x4 w0, w1;
          w0.x = pk2(o[0], o[1]); w0.y = pk2(o[2], o[3]); w0.z = pk2(o[4], o[5]); w0.w = pk2(o[6], o[7]);
          w1.x = pk2(o[8], o[9]); w1.y = pk2(o[10], o[11]); w1.z = pk2(o[12], o[13]); w1.w = pk2(o[14], o[15]);
          bf16_t* mp = MIXb + (size_t)(m0 + nt_) * 1024 + TYPE * 512 + h * 128 + nsg * 8;
          *(u32x4*)mp = w0; *(u32x4*)(mp + 64) = w1; } }
    __syncthreads();
}

__device__ __forceinline__ void ssd_conv_phase(const Params& P, int j) {
    const int gtid = blockIdx.x * 512 + otid(), gsz = gridDim.x * 512;
    const bf16_t* Pb = (const bf16_t*)(P.ws + WS_P); bf16_t* CONVB = (bf16_t*)(P.ws + WS_CONVB);
    const float* cw = P.in[17] + (size_t)j * 4 * 3072; const float* cb = P.in[18] + (size_t)j * 3072;
    for (int idx = gtid; idx < 1024 * 384; idx += gsz) {
        const int blk = idx / 384, c8 = idx - blk * 384, ch = c8 * 8, ms = blk * 16;
        float w[4][8], bias[8];
#pragma unroll
        for (int q = 0; q < 4; ++q) { const f32x4 a = *(const f32x4*)(cw + (size_t)q * 3072 + ch), b = *(const f32x4*)(cw + (size_t)q * 3072 + ch + 4);
            w[q][0] = a[0]; w[q][1] = a[1]; w[q][2] = a[2]; w[q][3] = a[3]; w[q][4] = b[0]; w[q][5] = b[1]; w[q][6] = b[2]; w[q][7] = b[3]; }
        { const f32x4 a = *(const f32x4*)(cb + ch), b = *(const f32x4*)(cb + ch + 4); bias[0] = a[0]; bias[1] = a[1]; bias[2] = a[2]; bias[3] = a[3]; bias[4] = b[0]; bias[5] = b[1]; bias[6] = b[2]; bias[7] = b[3]; }
        float f0[8], f1[8], f2[8];
#pragma unroll
        for (int e = 0; e < 8; ++e) { f0[e] = 0.f; f1[e] = 0.f; f2[e] = 0.f; }
        const bf16_t* src = Pb + (size_t)ms * SSDN + 2048 + ch;
        if ((ms & 2047) != 0) { const u32x4 q0 = *(const u32x4*)(src - 3 * SSDN), q1 = *(const u32x4*)(src - 2 * SSDN), q2 = *(const u32x4*)(src - SSDN);
#pragma unroll
            for (int e = 0; e < 8; ++e) { f0[e] = bfe(q0, e); f1[e] = bfe(q1, e); f2[e] = bfe(q2, e); } }
#pragma unroll 8
        for (int rr = 0; rr < 16; ++rr) {
            const u32x4 r3 = *(const u32x4*)(src + (size_t)rr * SSDN);
            float v[8];
#pragma unroll
            for (int e = 0; e < 8; ++e) { const float f3 = bfe(r3, e);
                const float a = fmaf(f3, w[3][e], fmaf(f2[e], w[2][e], fmaf(f1[e], w[1][e], fmaf(f0[e], w[0][e], bias[e]))));
                v[e] = a * sigm(a); f0[e] = f1[e]; f1[e] = f2[e]; f2[e] = f3; }
            u32x4 o; o.x = pk2(v[0], v[1]); o.y = pk2(v[2], v[3]); o.z = pk2(v[4], v[5]); o.w = pk2(v[6], v[7]);
            *(u32x4*)(CONVB + (size_t)(ms + rr) * 3072 + ch) = o;
        }
    }
    for (int idx = gtid; idx < MS * 384; idx += gsz) {
        const int ms = idx / 384, c8 = idx - ms * 384, ch = c8 * 8, b = ms >> 2, t = ms & 3;
        float v[8];
        { const f32x4 a = *(const f32x4*)(cb + ch), bb = *(const f32x4*)(cb + ch + 4); v[0] = a[0]; v[1] = a[1]; v[2] = a[2]; v[3] = a[3]; v[4] = bb[0]; v[5] = bb[1]; v[6] = bb[2]; v[7] = bb[3]; }
#pragma unroll
        for (int q = 0; q < 4; ++q) { const int tt = t - 3 + q; float raw[8];
            if (tt >= 0) { const u32x4 rv = *(const u32x4*)(Pb + (size_t)(MP + b * 4 + tt) * SSDN + 2048 + ch);
#pragma unroll
                for (int e = 0; e < 8; ++e) raw[e] = bfe(rv, e); }
            else { const float* cp = P.in[7] + ((size_t)(j * 128 + b) * 3 + (3 + tt)) * 3072 + ch; const f32x4 a = *(const f32x4*)cp, bb = *(const f32x4*)(cp + 4);
                raw[0] = a[0]; raw[1] = a[1]; raw[2] = a[2]; raw[3] = a[3]; raw[4] = bb[0]; raw[5] = bb[1]; raw[6] = bb[2]; raw[7] = bb[3]; }
            const f32x4 w0 = *(const f32x4*)(cw + (size_t)q * 3072 + ch), w1 = *(const f32x4*)(cw + (size_t)q * 3072 + ch + 4);
            v[0] += raw[0] * w0[0]; v[1] += raw[1] * w0[1]; v[2] += raw[2] * w0[2]; v[3] += raw[3] * w0[3];
            v[4] += raw[4] * w1[0]; v[5] += raw[5] * w1[1]; v[6] += raw[6] * w1[2]; v[7] += raw[7] * w1[3]; }
#pragma unroll
        for (int e = 0; e < 8; ++e) v[e] = v[e] * sigm(v[e]);
        u32x4 o; o.x = pk2(v[0], v[1]); o.y = pk2(v[2], v[3]); o.z = pk2(v[4], v[5]); o.w = pk2(v[6], v[7]);
        *(u32x4*)(CONVB + (size_t)(MP + ms) * 3072 + ch) = o;
    }
    { const float* GT = (const float*)(P.ws + WS_GT); float* DTB = (float*)(P.ws + WS_DTB); float* CS = (float*)(P.ws + WS_CS);
      const int lane = gtid & 63, gw = gtid >> 6, nw = gsz >> 6;
      for (int task = gw; task < 32 * (MT / 64); task += nw) { const int hd = task / (MT / 64), blk = task - hd * (MT / 64); const size_t idx = (size_t)hd * MT + blk * 64 + lane;
          const float dt = softplusf(GT[idx] + P.in[19][j * 32 + hd]); const float a = dt * -__expf(P.in[20][j * 32 + hd]); float cs;
          if (blk < MP / 64) cs = wave_scan_add(a, lane);
          else { const int pos = lane & 3; const float a1 = __shfl_up(a, 1), a2 = __shfl_up(a, 2), a3 = __shfl_up(a, 3); cs = a + (pos >= 1 ? a1 : 0.f) + (pos >= 2 ? a2 : 0.f) + (pos >= 3 ? a3 : 0.f); }
          DTB[idx] = dt; CS[idx] = cs; } }
}

struct SsdStep { int samp, b, head, m0, nvalid, last; };
__device__ __forceinline__ void ssd_decode(int item, int c, SsdStep& s) {
    if (item < 256) { s.samp = 0; s.b = item >> 5; s.head = item & 31; s.m0 = s.b * 2048 + c * 64; s.nvalid = 64; s.last = (c == 31); }
    else { const int r = item - 256; s.samp = 1; s.b = r >> 5; s.head = r & 31; s.m0 = MP + s.b * 4; s.nvalid = 4; s.last = 1; }
}
__device__ __forceinline__ void ssd_dma_issue(const SsdStep& s, const bf16_t* CONVB, const bf16_t* Pb, LAS unsigned char* lds, int tid, int wave) {
    const int g = s.head >> 3;
#pragma unroll
    for (int i = 0; i < 6; ++i) {
        const int q = i * 512 + tid; const int r = q / 48, cp = q - r * 48;
        const bf16_t* src;
        if (cp < 40) { const int col = cp < 8 ? s.head * 64 + cp * 8 : (cp < 24 ? 2048 + g * 128 + (cp - 8) * 8 : 2560 + g * 128 + (cp - 24) * 8); src = CONVB + (size_t)(s.m0 + r) * 3072 + col; }
        else src = Pb + (size_t)(s.m0 + r) * SSDN + s.head * 64 + (cp - 40) * 8;
        __builtin_amdgcn_global_load_lds((const unsigned*)src, (LAS unsigned*)(lds + i * 8192 + wave * 1024), 16, 0, 0);
    }
}

__device__ __forceinline__ void ssd_phase(const Params& P, LAS unsigned char* lds, int j) {
    const int tid = otid(), lane = tid & 63, wave = __builtin_amdgcn_readfirstlane(tid >> 6);
    constexpr int TILE_B = 64 * 41 * 16, TLD = 328;
    LAS bf16_t* XT = (LAS bf16_t*)(lds + 83968); LAS bf16_t* BwT = (LAS bf16_t*)(lds + 93184); LAS bf16_t* H0 = (LAS bf16_t*)(lds + 111616);
    LAS bf16_t* G = (LAS bf16_t*)(lds + 129024); LAS float* sc = (LAS float*)(lds + 138240);
    LAS float* Yb = (LAS float*)(lds + 139264);
    const bf16_t* Pb = (const bf16_t*)(P.ws + WS_P); const bf16_t* CONVB = (const bf16_t*)(P.ws + WS_CONVB);
    const float* DT = (const float*)(P.ws + WS_DTB);
    bf16_t* YG = (bf16_t*)(P.ws + WS_YG); float* SQ = (float*)(P.ws + WS_SQ);
    const int NIT = 256 + 4096;
    int item = blockIdx.x, c = 0;
    if (gridDim.x == 256) { const int x = item & 7, slot = item >> 3, pair = x * 4 + (slot >> 3); item = (pair >> 2) * 32 + (pair & 3) * 8 + (slot & 7); }
    if (item >= NIT) return;
    int eoff[6], hmul[6], gmul[6];
#pragma unroll
    for (int i = 0; i < 6; ++i) { int q = i * 512 + tid; if (q >= 64 * 41) q = 0; const int r = q / 41, cp = q - r * 41;
        if (cp < 8)       { eoff[i] = r * 3072 + cp * 8;                 hmul[i] = 64; gmul[i] = 0; }
        else if (cp < 24) { eoff[i] = r * 3072 + 2048 + (cp - 8) * 8;    hmul[i] = 0;  gmul[i] = 128; }
        else if (cp < 40) { eoff[i] = r * 3072 + 2560 + (cp - 24) * 8;   hmul[i] = 0;  gmul[i] = 128; }
        else              { eoff[i] = r * 3072;                          hmul[i] = 64; gmul[i] = 0; } }
#define SSD_DMA(st, buf) do { const int g_ = (st).head >> 3; LAS unsigned char* tb_ = lds + (buf) * TILE_B; _Pragma("unroll") for (int i = 0; i < 6; ++i) { if (i < 5 || wave == 0) { \
        const bf16_t* src_ = CONVB + (size_t)(st).m0 * 3072 + eoff[i] + (st).head * hmul[i] + g_ * gmul[i]; \
        __builtin_amdgcn_global_load_lds((const unsigned*)src_, (LAS unsigned*)(tb_ + i * 8192 + wave * 1024), 16, 0, 0); } } } while (0)
    const int zt = tid >> 3, zp8 = (tid & 7) * 8;
    SsdStep cur; ssd_decode(item, 0, cur);
    SSD_DMA(cur, 0);
    u32x4 znext = {0u, 0u, 0u, 0u};
    if (zt < cur.nvalid) znext = *(const u32x4*)(Pb + (size_t)(cur.m0 + zt) * SSDN + cur.head * 64 + zp8);
    const int pt = wave >> 1, nt0 = (wave & 1) * 4;
    const int hp = pt * 16 + (lane & 15), hn = (lane >> 4) * 4;
    f32x4 hst[4], hnx[4];
#pragma unroll
    for (int jj = 0; jj < 4; ++jj) { hst[jj] = (f32x4){0.f, 0.f, 0.f, 0.f}; hnx[jj] = (f32x4){0.f, 0.f, 0.f, 0.f}; }
    if (cur.samp) { const float* hin = P.in[6] + (size_t)((j * 128 + cur.b) * 32 + cur.head) * 8192;
#pragma unroll
        for (int jj = 0; jj < 4; ++jj) hnx[jj] = *(const f32x4*)(hin + hp * 128 + (nt0 + jj) * 16 + hn); }
    const float* CSB = (const float*)(P.ws + WS_CS);
    if (wave == 0) { float dt = 0.f; if (lane < cur.nvalid) dt = DT[(size_t)cur.head * MT + cur.m0 + lane];
        const float cs = CSB[(size_t)cur.head * MT + cur.m0 + min(lane, cur.nvalid - 1)]; sc[lane] = dt; sc[64 + lane] = cs; }
    int par = 0; float gtv = 0.f, gcs = 0.f;
    u32x4 zreg = {0u, 0u, 0u, 0u};
    u32x4 o_prev = {0u, 0u, 0u, 0u}; float sq_prev = 0.f; bf16_t* yp_prev = nullptr; float* sp_prev = nullptr; float* hp_prev = nullptr; f32x4 h_prev[4];
#pragma unroll
    for (int jj = 0; jj < 4; ++jj) h_prev[jj] = (f32x4){0.f, 0.f, 0.f, 0.f};
#define SSD_FLUSH() do { if (yp_prev) *(u32x4*)yp_prev = o_prev; if (sp_prev) *sp_prev = sq_prev; \
        if (hp_prev) { _Pragma("unroll") for (int jj = 0; jj < 4; ++jj) *(f32x4*)(hp_prev + (nt0 + jj) * 16) = h_prev[jj]; } yp_prev = nullptr; sp_prev = nullptr; hp_prev = nullptr; } while (0)
#pragma unroll 1
    for (;;) {
        const int nitem = cur.last ? item + (int)gridDim.x : item, nc = cur.last ? 0 : c + 1; const bool has_next = nitem < NIT;
        SsdStep nx = cur; if (has_next) ssd_decode(nitem, nc, nx);
        const float Dk = P.in[21][j * 32 + cur.head];
        LAS float* dts = sc + par * 128; LAS float* css = dts + 64;
        if (c == 0) {
#pragma unroll
            for (int jj = 0; jj < 4; ++jj) { hst[jj] = hnx[jj]; u32x2 w; w.x = pk2(hst[jj][0], hst[jj][1]); w.y = pk2(hst[jj][2], hst[jj][3]);
                *(LAS u32x2*)(H0 + hp * 136 + (nt0 + jj) * 16 + hn) = w; } }
        __builtin_amdgcn_s_waitcnt(0x0F70);
        RAW_BAR();
        const float csL = css[63];
        const int nvalid = cur.nvalid, m0 = cur.m0, head = cur.head;
        LAS bf16_t* tile = (LAS bf16_t*)(lds + par * TILE_B);
        const LAS bf16_t* CmP = tile + 192; const LAS bf16_t* BmP = tile + 64;
        zreg = znext;
        SSD_FLUSH();
        if (has_next) {
            if (wave == 0) { gtv = 0.f; if (lane < nx.nvalid) gtv = DT[(size_t)nx.head * MT + nx.m0 + lane]; gcs = CSB[(size_t)nx.head * MT + nx.m0 + min(lane, nx.nvalid - 1)]; }
            znext = (u32x4){0u, 0u, 0u, 0u};
            if (zt < nx.nvalid) znext = *(const u32x4*)(Pb + (size_t)(nx.m0 + zt) * SSDN + nx.head * 64 + zp8);
            if (cur.last) {
                if (nx.samp) { const float* hin = P.in[6] + (size_t)((j * 128 + nx.b) * 32 + nx.head) * 8192;
#pragma unroll
                    for (int jj = 0; jj < 4; ++jj) hnx[jj] = *(const f32x4*)(hin + hp * 128 + (nt0 + jj) * 16 + hn); }
                else {
#pragma unroll
                    for (int jj = 0; jj < 4; ++jj) hnx[jj] = (f32x4){0.f, 0.f, 0.f, 0.f}; } }
            SSD_DMA(nx, par ^ 1);
        }
        { const int rp = tid >> 4, c16 = tid & 15, r0 = 2 * rp, r1 = r0 + 1;
          u32x4 bv0 = {0u, 0u, 0u, 0u}, bv1 = bv0; float wl0 = 0.f, wl1 = 0.f;
          if (r0 < nvalid) { bv0 = *(const LAS u32x4*)(BmP + r0 * TLD + c16 * 8); wl0 = __expf(csL - css[r0]) * dts[r0]; }
          if (r1 < nvalid) { bv1 = *(const LAS u32x4*)(BmP + r1 * TLD + c16 * 8); wl1 = __expf(csL - css[r1]) * dts[r1]; }
#pragma unroll
          for (int e = 0; e < 8; ++e) *(LAS unsigned*)(BwT + (c16 * 8 + e) * 72 + (r0 ^ ((c16 & 7) << 3))) = pk2(bfe(bv0, e) * wl0, bfe(bv1, e) * wl1); }
        if (tid < 256) { const int rp = tid >> 3, c8 = tid & 7, r0 = 2 * rp, r1 = r0 + 1;
          u32x4 xv0 = {0u, 0u, 0u, 0u}, xv1 = xv0;
          if (r0 < nvalid) xv0 = *(const LAS u32x4*)(tile + r0 * TLD + c8 * 8);
          if (r1 < nvalid) xv1 = *(const LAS u32x4*)(tile + r1 * TLD + c8 * 8);
#pragma unroll
          for (int e = 0; e < 8; ++e) *(LAS unsigned*)(XT + (c8 * 8 + e) * 72 + (r0 ^ (c8 << 3))) = (unsigned)bfr(xv0, e) | ((unsigned)bfr(xv1, e) << 16); }
        { const int tt = wave >> 1, st0 = (wave & 1) * 2;
          f32x4 ca[2] = {(f32x4){0.f, 0.f, 0.f, 0.f}, (f32x4){0.f, 0.f, 0.f, 0.f}};
#pragma unroll
          for (int ks = 0; ks < 4; ++ks) { const bf16x8 bb = ldsfrag(CmP, tt * 16, TLD, ks * 32, lane);
#pragma unroll
              for (int jj = 0; jj < 2; ++jj) { const bf16x8 a = ldsfrag(BmP, (st0 + jj) * 16, TLD, ks * 32, lane); ca[jj] = mma(a, bb, ca[jj]); } }
          const int t = tt * 16 + (lane & 15); const float cst = css[t];
#pragma unroll
          for (int jj = 0; jj < 2; ++jj) { const int s0 = (st0 + jj) * 16 + (lane >> 4) * 4;
              const f32x4 cs4 = *(const LAS f32x4*)(css + s0), dt4 = *(const LAS f32x4*)(dts + s0); float v[4];
#pragma unroll
              for (int r = 0; r < 4; ++r) v[r] = (s0 + r <= t && s0 + r < nvalid) ? ca[jj][r] * __expf(cst - cs4[r]) * dt4[r] : 0.f;
              u32x2 w; w.x = pk2(v[0], v[1]); w.y = pk2(v[2], v[3]); *(LAS u32x2*)(G + t * 72 + s0) = w; } }
        RAW_BAR();
        { const int tt = wave >> 1, pp0 = (wave & 1) * 2;
          f32x4 y[2] = {(f32x4){0.f, 0.f, 0.f, 0.f}, (f32x4){0.f, 0.f, 0.f, 0.f}};
#pragma unroll
          for (int ks = 0; ks < 4; ++ks) { const bf16x8 bb = ldsfrag(CmP, tt * 16, TLD, ks * 32, lane);
#pragma unroll
              for (int jj = 0; jj < 2; ++jj) { const bf16x8 a = ldsfrag(H0, (pp0 + jj) * 16, 136, ks * 32, lane); y[jj] = mma(a, bb, y[jj]); } }
          const int t = tt * 16 + (lane & 15); const float ew = __expf(css[t]);
          y[0] = y[0] * ew; y[1] = y[1] * ew;
#pragma unroll
          for (int ks = 0; ks < 2; ++ks) { const bf16x8 bb = ldsfrag(G, tt * 16, 72, ks * 32, lane);
#pragma unroll
              for (int jj = 0; jj < 2; ++jj) { const bf16x8 a = ldsfrag_swz(XT, (pp0 + jj) * 16, 72, ks * 32, lane); y[jj] = mma(a, bb, y[jj]); } }
#pragma unroll
          for (int jj = 0; jj < 2; ++jj) { const int p0 = (pp0 + jj) * 16 + (lane >> 4) * 4;
              const u32x2 xw = *(const LAS u32x2*)(tile + t * TLD + p0);
              f32x4 o; o[0] = y[jj][0] + Dk * __uint_as_float(xw.x << 16); o[1] = y[jj][1] + Dk * __uint_as_float(xw.x & 0xffff0000u);
              o[2] = y[jj][2] + Dk * __uint_as_float(xw.y << 16); o[3] = y[jj][3] + Dk * __uint_as_float(xw.y & 0xffff0000u);
              *(LAS f32x4*)(Yb + t * 68 + p0) = o; } }
        { const float dec = __expf(csL);
#pragma unroll
          for (int jj = 0; jj < 4; ++jj) hst[jj] = hst[jj] * dec;
#pragma unroll
          for (int ks = 0; ks < 2; ++ks) { const bf16x8 bb = ldsfrag_swz(XT, pt * 16, 72, ks * 32, lane);
#pragma unroll
              for (int jj = 0; jj < 4; ++jj) { const bf16x8 a = ldsfrag_swz(BwT, (nt0 + jj) * 16, 72, ks * 32, lane); hst[jj] = mma(a, bb, hst[jj]); } } }
        RAW_BAR();
        { const int t = tid >> 3, p8 = (tid & 7) * 8;
          const f32x4 y0 = *(const LAS f32x4*)(Yb + t * 68 + p8), y1 = *(const LAS f32x4*)(Yb + t * 68 + p8 + 4);
          float yg[8]; float sq = 0.f;
#pragma unroll
          for (int e = 0; e < 8; ++e) { const float z = bfe(zreg, e); const float yv = (e < 4 ? y0[e & 3] : y1[e & 3]) * (z * sigm(z)); yg[e] = yv; sq += yv * yv; }
          sq += __shfl_xor(sq, 1); sq += __shfl_xor(sq, 2); sq += __shfl_xor(sq, 4);
          if (t < nvalid) { o_prev.x = pk2(yg[0], yg[1]); o_prev.y = pk2(yg[2], yg[3]); o_prev.z = pk2(yg[4], yg[5]); o_prev.w = pk2(yg[6], yg[7]);
              yp_prev = YG + (size_t)(m0 + t) * 2048 + head * 64 + p8;
              if ((tid & 7) == 0) { sq_prev = sq; sp_prev = SQ + (size_t)(m0 + t) * 32 + head; } } }
        if (cur.last) { float* hout = P.out + (cur.samp ? O_SH + (size_t)((j * 128 + cur.b) * 32 + head) * 8192 : O_PH + (size_t)((j * 8 + cur.b) * 32 + head) * 8192);
            hp_prev = hout + hp * 128 + hn;
#pragma unroll
            for (int jj = 0; jj < 4; ++jj) h_prev[jj] = hst[jj]; }
        else {
#pragma unroll
            for (int jj = 0; jj < 4; ++jj) { u32x2 w; w.x = pk2(hst[jj][0], hst[jj][1]); w.y = pk2(hst[jj][2], hst[jj][3]); *(LAS u32x2*)(H0 + hp * 136 + (nt0 + jj) * 16 + hn) = w; } }
        if (!has_next) break;
        if (wave == 0) { LAS float* nd = sc + (par ^ 1) * 128; nd[lane] = gtv; nd[64 + lane] = gcs; }
        cur = nx; item = nitem; c = nc; par ^= 1;
    }
    SSD_FLUSH();
#undef SSD_FLUSH
#undef SSD_DMA
    asm volatile("s_waitcnt vmcnt(0)" ::: "memory");
    __syncthreads();
}

__device__ __forceinline__ void ssd_norm_phase(const Params& P, int j) {
    const int gtid = blockIdx.x * 512 + otid(), gsz = gridDim.x * 512;
    const bf16_t* YG = (const bf16_t*)(P.ws + WS_YG); const float* SQ = (const float*)(P.ws + WS_SQ); bf16_t* MIXb = (bf16_t*)(P.ws + WS_MIX);
    const float* ng = P.in[22] + (size_t)j * 2048;
    for (int idx0 = gtid; idx0 < MT * 256; idx0 += 4 * gsz) {
        f32x4 s0[4], s1[4]; u32x4 yv[4];
#pragma unroll
        for (int q = 0; q < 4; ++q) { const int idx = idx0 + q * gsz; if (idx < MT * 256) { const int m = idx >> 8, c8 = idx & 255, g = c8 >> 6;
            s0[q] = *(const f32x4*)(SQ + (size_t)m * 32 + g * 8); s1[q] = *(const f32x4*)(SQ + (size_t)m * 32 + g * 8 + 4); yv[q] = *(const u32x4*)(YG + (size_t)m * 2048 + c8 * 8); } }
#pragma unroll
        for (int q = 0; q < 4; ++q) { const int idx = idx0 + q * gsz; if (idx < MT * 256) { const int m = idx >> 8, c8 = idx & 255;
            const float ss = ((s0[q][0] + s0[q][1]) + (s0[q][2] + s0[q][3])) + ((s1[q][0] + s1[q][1]) + (s1[q][2] + s1[q][3]));
            const float sc = rsqrtf(ss * (1.f / 512.f) + LN_EPS);
            const f32x4 g0 = *(const f32x4*)(ng + c8 * 8), g1 = *(const f32x4*)(ng + c8 * 8 + 4);
            u32x4 w; w.x = pk2(bfe(yv[q], 0) * sc * g0[0], bfe(yv[q], 1) * sc * g0[1]); w.y = pk2(bfe(yv[q], 2) * sc * g0[2], bfe(yv[q], 3) * sc * g0[3]);
            w.z = pk2(bfe(yv[q], 4) * sc * g1[0], bfe(yv[q], 5) * sc * g1[1]); w.w = pk2(bfe(yv[q], 6) * sc * g1[2], bfe(yv[q], 7) * sc * g1[3]);
            *(u32x4*)(MIXb + (size_t)m * 2048 + c8 * 8) = w; } }
    }
    const bf16_t* Pb = (const bf16_t*)(P.ws + WS_P);
    for (int idx = gtid; idx < (8 + 128) * 3 * 3072; idx += gsz) {
        const int ch = idx % 3072, rw = idx / 3072, w = rw % 3, bb = rw / 3;
        if (bb < 8) P.out[O_PCV + ((size_t)(j * 8 + bb) * 3 + w) * 3072 + ch] = bf2f(Pb[(size_t)(bb * 2048 + 2045 + w) * SSDN + 2048 + ch]);
        else { const int b = bb - 8; P.out[O_SCV + ((size_t)(j * 128 + b) * 3 + w) * 3072 + ch] = bf2f(Pb[(size_t)(MP + b * 4 + 1 + w) * SSDN + 2048 + ch]); }
    }
}

template <int EPI> __device__ __forceinline__ void small_gemm(LAS unsigned char* lds, const bf16_t* A, const bf16_t* Bt, int N, int K, bf16_t* O, const bf16_t* X, bf16_t* Y) {
    const int tid = otid(), lane = tid & 63, wave = __builtin_amdgcn_readfirstlane(tid >> 6);
    LAS float* red = (LAS float*)lds;
    LAS bf16_t* stg = (LAS bf16_t*)(lds + wave * 13824);
    const int ksl = K >> 3, nblk = ksl >> 6, nunits = 16 * (N >> 6);
    const int lr = lane >> 3, lc = (lane & 7) * 8;
    for (int u = blockIdx.x; u < nunits; u += gridDim.x) {
        const int rb = u & 15, cb = u >> 4;
        f32x4 acc[2][4];
#pragma unroll
        for (int m = 0; m < 2; ++m)
#pragma unroll
            for (int n = 0; n < 4; ++n) acc[m][n] = (f32x4){0.f, 0.f, 0.f, 0.f};
        const bf16_t* ap = A + (size_t)(rb * 32 + lr) * K + wave * ksl + lc;
        const bf16_t* bp = Bt + (size_t)(cb * 64 + lr) * K + wave * ksl + lc;
        u32x4 g[12];
#pragma unroll
        for (int i = 0; i < 4; ++i) g[i] = *(const u32x4*)(ap + (size_t)(i * 8) * K);
#pragma unroll
        for (int i = 0; i < 8; ++i) g[4 + i] = *(const u32x4*)(bp + (size_t)(i * 8) * K);
#pragma unroll 1
        for (int kb = 0; kb < nblk; ++kb) {
#pragma unroll
            for (int i = 0; i < 12; ++i) *(LAS u32x4*)(stg + (i * 8 + lr) * 72 + lc) = g[i];
            if (kb + 1 < nblk) {
#pragma unroll
                for (int i = 0; i < 4; ++i) g[i] = *(const u32x4*)(ap + (size_t)(i * 8) * K + (kb + 1) * 64);
#pragma unroll
                for (int i = 0; i < 8; ++i) g[4 + i] = *(const u32x4*)(bp + (size_t)(i * 8) * K + (kb + 1) * 64);
            }
#pragma unroll
            for (int q = 0; q < 2; ++q) { const bf16x8 a0 = ldsfrag(stg, 0, 72, q * 32, lane), a1 = ldsfrag(stg, 16, 72, q * 32, lane);
#pragma unroll
                for (int n = 0; n < 4; ++n) { const bf16x8 bq = ldsfrag(stg, 32 + n * 16, 72, q * 32, lane); acc[0][n] = mma(a0, bq, acc[0][n]); acc[1][n] = mma(a1, bq, acc[1][n]); } }
        }
        __syncthreads();
#pragma unroll
        for (int m = 0; m < 2; ++m)
#pragma unroll
            for (int n = 0; n < 4; ++n)
#pragma unroll
                for (int r = 0; r < 4; ++r) red[(wave * 32 + m * 16 + (lane >> 4) * 4 + r) * 68 + n * 16 + (lane & 15)] = acc[m][n][r];
        __syncthreads();
        { const int row = tid >> 4, c4 = (tid & 15) * 4;
          f32x4 s = *(const LAS f32x4*)(red + row * 68 + c4);
#pragma unroll
          for (int w = 1; w < 8; ++w) s = s + *(const LAS f32x4*)(red + (w * 32 + row) * 68 + c4);
          const int grow = rb * 32 + row, gcol = cb * 64 + c4;
          if (EPI == 2) { const u32x2 x = *(const u32x2*)(X + (size_t)grow * 1024 + gcol); u32x2 w2;
              w2.x = pk2(s[0] + DN_ALPHA * __uint_as_float(x.x << 16), s[1] + DN_ALPHA * __uint_as_float(x.x & 0xffff0000u));
              w2.y = pk2(s[2] + DN_ALPHA * __uint_as_float(x.y << 16), s[3] + DN_ALPHA * __uint_as_float(x.y & 0xffff0000u));
              *(u32x2*)(Y + (size_t)grow * 1024 + gcol) = w2; }
          else { if (EPI == 1) {
#pragma unroll
                  for (int q = 0; q < 4; ++q) { const float a = fmaxf(s[q], 0.f); s[q] = a * a; } }
              u32x2 w2; w2.x = pk2(s[0], s[1]); w2.y = pk2(s[2], s[3]); *(u32x2*)(O + (size_t)grow * N + gcol) = w2; } }
        __syncthreads();
    }
}

#ifndef REP_GEMM
#define REP_GEMM 1
#endif
#ifndef REP_P0
#define REP_P0 1
#endif
#ifndef REP_AB
#define REP_AB 1
#endif
#ifndef REP_S2
#define REP_S2 1
#endif
#ifndef REP_CONV
#define REP_CONV 1
#endif
#ifndef REP_BAR
#define REP_BAR 1
#endif
#ifndef REP_LN
#define REP_LN 1
#endif
#ifndef REP_SG
#define REP_SG 1
#endif
__global__ void __launch_bounds__(512) mega_fwd(Params P) {
    extern __shared__ __attribute__((aligned(16))) unsigned char smem[];
    LAS unsigned char* lds = (LAS unsigned char*)smem;
    const int tid = otid();
    volatile LAS unsigned* bst = (volatile LAS unsigned*)(lds + LDS_BAR_OFF);
    if (tid < 64) bst[tid] = 0u;
    __syncthreads();
    XcdBarrier bar = xcd_barrier_post((unsigned*)(P.ws + WS_CTL), bst);
    cg::grid_group grid = cg::this_grid();
#define GRID_BAR() do { for (int rb_ = 0; rb_ < REP_BAR; ++rb_) xcd_barrier(bar); } while (0)

#ifndef SKIP_P0
    for (int rep_ = 0; rep_ < REP_P0; ++rep_)
    p0_prologue(P, lds);
#endif
    if (P.ws == nullptr) grid.sync();
    GRID_BAR();

    const bf16_t* XB = (const bf16_t*)(P.ws + WS_XB); bf16_t* Y = (bf16_t*)(P.ws + WS_Y);
    bf16_t* Pb = (bf16_t*)(P.ws + WS_P); bf16_t* MIXb = (bf16_t*)(P.ws + WS_MIX); float* GT = (float*)(P.ws + WS_GT);
#pragma unroll 1
    for (int l = 0; l < 4; ++l) {
        const int j = l >> 1, ssd = l & 1;
        { const bf16_t* Bt = ssd ? (const bf16_t*)(P.ws + WS_WSSDIN) + (size_t)j * SSDN * 1024 : (const bf16_t*)(P.ws + WS_WABIN) + (size_t)j * ABN * 1024;
          const int N = ssd ? SSDN : ABN;
          pg8::Gemm g{XB, Bt, MP, N, 1024}; pg8::StaticOrder S; S.init(MP, N, gridDim.x, blockIdx.x);
          pg8::EpiB<0> E{Pb, N};
#ifndef SKIP_G1
          for (int rep_ = 0; rep_ < REP_GEMM; ++rep_)
          pg8::gemm_phase<pg8::EpiB<0>, pg8::StaticOrder>(lds, g, S, E, nullptr);
#endif
#ifndef SKIP_GATES
          for (int rep_ = 0; rep_ < REP_SG; ++rep_)
          small_gemm<0>(lds, XB + (size_t)MP * 1024, Bt, N, 1024, Pb + (size_t)MP * N, nullptr, nullptr);
          gates_phase(lds, XB, ssd ? (const bf16_t*)(P.ws + WS_WSSDG) + (size_t)j * 32768 : (const bf16_t*)(P.ws + WS_WABG) + (size_t)j * 32768, GT);
#endif
 }
        GRID_BAR();
        if (!ssd) {
#ifndef SKIP_A2
            for (int rep_ = 0; rep_ < REP_AB; ++rep_)
            for (int w = blockIdx.x; w < 2 * NITEM; w += gridDim.x) { if (w < NITEM) ab_delta_item<0>(P, lds, j, w); else ab_delta_item<1>(P, lds, j, w - NITEM); }
#endif
            GRID_BAR();
#ifndef SKIP_A3
            for (int rep_ = 0; rep_ < REP_AB; ++rep_)
            ab_scan_phase(P, lds, j);
#endif
            GRID_BAR();
#ifndef SKIP_A4
            for (int rep_ = 0; rep_ < REP_AB; ++rep_)
            for (int w = blockIdx.x; w < 2 * NITEM; w += gridDim.x) { if (w < NITEM) ab_out_item<0>(P, lds, j, w); else ab_out_item<1>(P, lds, j, w - NITEM); }
#endif
            GRID_BAR();
        } else {
            for (int rep_ = 0; rep_ < REP_CONV; ++rep_)
            ssd_conv_phase(P, j);
            GRID_BAR();
#ifndef SKIP_S2
            for (int rep_ = 0; rep_ < REP_S2; ++rep_)
            ssd_phase(P, lds, j);
#endif
            GRID_BAR();
#ifndef SKIP_S3
            for (int rep_ = 0; rep_ < REP_CONV; ++rep_)
            ssd_norm_phase(P, j);
#endif
            GRID_BAR();
        }
        { const bf16_t* Bt = ssd ? (const bf16_t*)(P.ws + WS_WSSDOUT) + (size_t)j * 1024 * 2048 : (const bf16_t*)(P.ws + WS_WABOUT) + (size_t)j * 1024 * 1024;
          const int K = ssd ? 2048 : 1024;
          pg8::Gemm g{MIXb, Bt, MP, 1024, K}; pg8::StaticOrder S; S.init(MP, 1024, gridDim.x, blockIdx.x);
          pg8::EpiRes E{XB, Y, 1024, DN_ALPHA};
#ifndef SKIP_G2
          for (int rep_ = 0; rep_ < REP_GEMM; ++rep_)
          pg8::gemm_phase<pg8::EpiRes, pg8::StaticOrder>(lds, g, S, E, nullptr);
#endif
          for (int rep_ = 0; rep_ < REP_SG; ++rep_)
          small_gemm<2>(lds, MIXb + (size_t)MP * K, Bt, 1024, K, nullptr, XB + (size_t)MP * 1024, Y + (size_t)MP * 1024);
 }
        GRID_BAR();
        for (int rep_ = 0; rep_ < REP_LN; ++rep_)
        ln_phase(Y, P.in[26] + (size_t)l * 1024, P.in[27] + (size_t)l * 1024, nullptr, (bf16_t*)(P.ws + WS_XB));
        GRID_BAR();
        { pg8::Gemm g{XB, (const bf16_t*)(P.ws + WS_W1) + (size_t)l * 4096 * 1024, MP, DFF, 1024}; pg8::StaticOrder S; S.init(MP, DFF, gridDim.x, blockIdx.x);
          pg8::EpiB<1> E{Pb, DFF};
#ifndef SKIP_G3
          for (int rep_ = 0; rep_ < REP_GEMM; ++rep_)
          pg8::gemm_phase<pg8::EpiB<1>, pg8::StaticOrder>(lds, g, S, E, nullptr);
#endif
          for (int rep_ = 0; rep_ < REP_SG; ++rep_)
          small_gemm<1>(lds, XB + (size_t)MP * 1024, g.Bt, DFF, 1024, Pb + (size_t)MP * DFF, nullptr, nullptr);
 }
        GRID_BAR();
        { pg8::Gemm g{Pb, (const bf16_t*)(P.ws + WS_W2) + (size_t)l * 1024 * 4096, MP, 1024, DFF}; pg8::StaticOrder S; S.init(MP, 1024, gridDim.x, blockIdx.x);
          pg8::EpiRes E{XB, Y, 1024, DN_ALPHA};
#ifndef SKIP_G4
          for (int rep_ = 0; rep_ < REP_GEMM; ++rep_)
          pg8::gemm_phase<pg8::EpiRes, pg8::StaticOrder>(lds, g, S, E, nullptr);
#endif
          for (int rep_ = 0; rep_ < REP_SG; ++rep_)
          small_gemm<2>(lds, Pb + (size_t)MP * DFF, g.Bt, 1024, DFF, nullptr, XB + (size_t)MP * 1024, Y + (size_t)MP * 1024);
 }
        GRID_BAR();
        for (int rep_ = 0; rep_ < REP_LN; ++rep_)
        ln_phase(Y, P.in[28] + (size_t)l * 1024, P.in[29] + (size_t)l * 1024, l == 3 ? P.out : nullptr, (bf16_t*)(P.ws + WS_XB));
        if (l < 3) GRID_BAR();
    }
}

extern "C" void kernel_launch(void* const* d_in, const int* in_sizes, int n_in, void* d_out, int out_size, void* d_ws, size_t ws_size, hipStream_t stream) {
    static int grid = 0;
    if (grid == 0) {
        if (n_in != 30 || (size_t)out_size != O_END || ws_size < WS_END) { fprintf(stderr, "kernel_launch: unexpected shapes (n_in %d, out %d, ws %zu)\n", n_in, out_size, ws_size); grid = -1; return; }
        int dev = 0, cus = 0, per_cu = 0;
        (void)hipGetDevice(&dev); (void)hipDeviceGetAttribute(&cus, hipDeviceAttributeMultiprocessorCount, dev);
        (void)hipFuncSetAttribute((const void*)mega_fwd, hipFuncAttributeMaxDynamicSharedMemorySize, LDS_BYTES);
        (void)hipOccupancyMaxActiveBlocksPerMultiprocessor(&per_cu, (const void*)mega_fwd, 512, LDS_BYTES);
        if (per_cu < 1) { fprintf(stderr, "kernel_launch: occupancy query says %d blocks per CU\n", per_cu); per_cu = 1; }
        grid = cus * per_cu; if (grid > 256) grid = 256;
        (void)hipGetLastError();
    }
    if (grid < 0) return;
    (void)hipMemsetAsync((char*)d_ws + WS_CTL, 0, CTL_BYTES, stream);
    Params p{};
    for (int i = 0; i < 30; ++i) p.in[i] = (const float*)d_in[i];
    p.out = (float*)d_out; p.ws = (unsigned char*)d_ws;
    void* args[] = {&p};
    hipError_t e = hipLaunchCooperativeKernel((const void*)mega_fwd, dim3(grid), dim3(512), args, LDS_BYTES, stream);
    if (e != hipSuccess) fprintf(stderr, "kernel_launch: cooperative launch failed: %s (grid %d)\n", hipGetErrorString(e), grid);
}
```
